# Optimizing an MI355X kernel written in HIP

```python
import math
import jax
import jax.numpy as jnp
from jax import lax
import numpy as np


D_MODEL = 1024
BATCH = 2
SEQ = 16384
DEPTH = 4

CTX_LEN = 256
GRID_W = 64
N_MIXERS = 4
Q_BLOCK = 128
WINDOW = 128
ROPE_THETA = 10000.0
NORM_EPS = 1e-6
WIDTH = D_MODEL

A_HEADS = 16
A_Q_LORA = 256
A_KV_LORA = 128
A_NOPE = 64
A_ROPE = 32
A_V = 64
A_IN = A_Q_LORA + A_KV_LORA + A_ROPE + WIDTH

B_HEADS = 8
B_HEAD = 64
B_IN = 3 * (2 * B_HEADS * B_HEAD) + WIDTH

C_HEADS = 8
C_KV_HEADS = 2
C_HEAD = 128
C_IN = (C_HEADS + 2 * C_KV_HEADS) * C_HEAD + WIDTH

D_HEADS = 16
D_KV_HEADS = 2
D_HEAD = 64
D_IN = (D_HEADS + 2 * D_KV_HEADS) * D_HEAD + WIDTH

DEEPNORM_ALPHA = (2 * DEPTH) ** 0.25
DEEPNORM_BETA = (8 * DEPTH) ** -0.25

kernel_name = 'hybrid_interleaved_mla_diff_gqa_swa_dit'


def rms_norm(x, g):
    xf = x.astype(jnp.float32)
    y = xf * lax.rsqrt(jnp.mean(xf * xf, axis=-1, keepdims=True) + NORM_EPS)
    return (y * g.astype(jnp.float32)).astype(x.dtype)


def layer_norm(x, g, b):
    xf = x.astype(jnp.float32)
    xc = xf - jnp.mean(xf, axis=-1, keepdims=True)
    var = jnp.mean(xc * xc, axis=-1, keepdims=True)
    y = xc * lax.rsqrt(var + NORM_EPS) * g.astype(jnp.float32) + b.astype(jnp.float32)
    return y.astype(x.dtype)


def axial_rope_tables(rows, rot_dim):
    row = jnp.repeat(jnp.arange(rows, dtype=jnp.float32), GRID_W)
    col = jnp.tile(jnp.arange(GRID_W, dtype=jnp.float32), rows)
    n_freq = rot_dim // 4
    inv_freq = ROPE_THETA ** (-jnp.arange(n_freq, dtype=jnp.float32) / n_freq)
    ang = jnp.concatenate([row[:, None] * inv_freq, col[:, None] * inv_freq], axis=-1)
    return jnp.cos(ang)[:, None, :], jnp.sin(ang)[:, None, :]


def apply_rope(x, cos, sin):
    half = x.shape[-1] // 2
    x1 = x[..., :half].astype(jnp.float32)
    x2 = x[..., half:].astype(jnp.float32)
    return jnp.concatenate([x1 * cos - x2 * sin, x2 * cos + x1 * sin], axis=-1).astype(x.dtype)


def adaln(cvec, w, b):
    m = jax.nn.silu(cvec) @ w + b
    return jnp.split(m, 3, axis=-1)


def gated(o, gate):
    return o.reshape(gate.shape) * jax.nn.silu(gate)


def dense_attention(q, k, v, scale):
    bsz, s_len, hk, g, d = q.shape
    dv = v.shape[-1]
    nb = s_len // Q_BLOCK
    q_blocks = jnp.moveaxis(q.reshape(bsz, nb, Q_BLOCK, hk, g, d), 1, 0)

    def one_block(qb):
        s = jnp.einsum('bqhgd,bkhd->bhgqk', qb, k).astype(jnp.float32) * scale
        p = jax.nn.softmax(s, axis=-1).astype(v.dtype)
        return jnp.einsum('bhgqk,bkhv->bqhgv', p, v)

    o = lax.map(one_block, q_blocks)
    return jnp.moveaxis(o, 0, 1).reshape(bsz, s_len, hk, g, dv)


def prefix_attention(q, k, v, q_c, k_c, v_c, scale, need_ctx):
    o = dense_attention(q, jnp.concatenate([k, k_c], axis=1), jnp.concatenate([v, v_c], axis=1), scale)
    o_c = dense_attention(q_c, k_c, v_c, scale) if need_ctx else None
    return o, o_c


def window_sink_attention(q, k, v, k_c, v_c, sinks, scale):
    bsz, s_len, hk, g, d = q.shape
    dv = v.shape[-1]
    nb = s_len // Q_BLOCK
    kw = 3 * Q_BLOCK
    pad = ((0, 0), (Q_BLOCK, Q_BLOCK), (0, 0), (0, 0))
    k_pad = jnp.pad(k, pad)
    v_pad = jnp.pad(v, pad)
    offs_q = jnp.arange(Q_BLOCK)
    offs_k = jnp.arange(kw) - Q_BLOCK
    in_band = jnp.abs(offs_k[None, :] - offs_q[:, None]) <= WINDOW
    sink_logit = sinks.reshape(hk, g).astype(jnp.float32)[None, :, :, None, None]

    def one_block(n):
        start = n * Q_BLOCK
        qb = lax.dynamic_slice_in_dim(q, start, Q_BLOCK, axis=1)
        kb = lax.dynamic_slice_in_dim(k_pad, start, kw, axis=1)
        vb = lax.dynamic_slice_in_dim(v_pad, start, kw, axis=1)
        kpos = start + offs_k
        valid = in_band & ((kpos >= 0) & (kpos < s_len))[None, :]
        s_loc = jnp.einsum('bqhgd,bkhd->bhgqk', qb, kb).astype(jnp.float32) * scale
        s_loc = jnp.where(valid, s_loc, -jnp.inf)
        s_ctx = jnp.einsum('bqhgd,bkhd->bhgqk', qb, k_c).astype(jnp.float32) * scale
        s_sink = jnp.broadcast_to(sink_logit, s_loc.shape[:-1] + (1,))
        p = jax.nn.softmax(jnp.concatenate([s_loc, s_ctx, s_sink], axis=-1), axis=-1).astype(v.dtype)
        o_loc = jnp.einsum('bhgqk,bkhv->bqhgv', p[..., :kw], vb)
        o_ctx = jnp.einsum('bhgqk,bkhv->bqhgv', p[..., kw:kw + k_c.shape[1]], v_c)
        return o_loc + o_ctx

    o = lax.map(one_block, jnp.arange(nb))
    return jnp.moveaxis(o, 0, 1).reshape(bsz, s_len, hk, g, dv)


def context_sink_attention(q_c, k_c, v_c, sinks, scale):
    hk, g = q_c.shape[2], q_c.shape[3]
    s = jnp.einsum('bqhgd,bkhd->bhgqk', q_c, k_c).astype(jnp.float32) * scale
    s_sink = jnp.broadcast_to(sinks.reshape(hk, g).astype(jnp.float32)[None, :, :, None, None], s.shape[:-1] + (1,))
    p = jax.nn.softmax(jnp.concatenate([s, s_sink], axis=-1), axis=-1)[..., :-1].astype(v_c.dtype)
    return jnp.einsum('bhgqk,bkhv->bqhgv', p, v_c)


def mla_mixer(h, h_c, rows, need_ctx, w_in, g_qa, w_qb, g_kva, w_kvb):
    cos, sin = axial_rope_tables(rows, A_ROPE)
    splits = [A_Q_LORA, A_Q_LORA + A_KV_LORA, A_Q_LORA + A_KV_LORA + A_ROPE]

    def project(t, rope):
        bsz, n = t.shape[:2]
        q_lat, kv_lat, k_pe, gate = jnp.split(t @ w_in, splits, axis=-1)
        q = (rms_norm(q_lat, g_qa) @ w_qb).reshape(bsz, n, A_HEADS, A_NOPE + A_ROPE)
        kv = (rms_norm(kv_lat, g_kva) @ w_kvb).reshape(bsz, n, A_HEADS, A_NOPE + A_V)
        q_nope, q_pe = q[..., :A_NOPE], q[..., A_NOPE:]
        k_nope, v = kv[..., :A_NOPE], kv[..., A_NOPE:]
        k_pe = k_pe[:, :, None, :]
        if rope:
            q_pe = apply_rope(q_pe, cos, sin)
            k_pe = apply_rope(k_pe, cos, sin)
        q = jnp.concatenate([q_nope, q_pe], axis=-1)[:, :, :, None, :]
        k = jnp.concatenate([k_nope, jnp.broadcast_to(k_pe, (bsz, n, A_HEADS, A_ROPE))], axis=-1)
        return q, k, v, gate

    q, k, v, gate = project(h, True)
    q_c, k_c, v_c, gate_c = project(h_c, False)
    o, o_c = prefix_attention(q, k, v, q_c, k_c, v_c, (A_NOPE + A_ROPE) ** -0.5, need_ctx)
    return gated(o, gate), (gated(o_c, gate_c) if need_ctx else None)


def diff_mixer(h, h_c, rows, need_ctx, layer_idx, w_in, lam, g_sub):
    cos, sin = axial_rope_tables(rows, B_HEAD)
    lambda_init = 0.8 - 0.6 * math.exp(-0.3 * layer_idx)
    lam = lam.astype(jnp.float32)
    lam_full = jnp.exp(jnp.sum(lam[0] * lam[1])) - jnp.exp(jnp.sum(lam[2] * lam[3])) + lambda_init
    scale = B_HEAD ** -0.5

    def project(t, rope):
        bsz, n = t.shape[:2]
        q, k, v, gate = jnp.split(t @ w_in, 4, axis=-1)
        q = q.reshape(bsz, n, 2 * B_HEADS, B_HEAD)
        k = k.reshape(bsz, n, 2 * B_HEADS, B_HEAD)
        if rope:
            q = apply_rope(q, cos, sin)
            k = apply_rope(k, cos, sin)
        q = q.reshape(bsz, n, B_HEADS, 2, B_HEAD)
        k = k.reshape(bsz, n, B_HEADS, 2, B_HEAD)
        v = v.reshape(bsz, n, B_HEADS, 2 * B_HEAD)
        return q, k, v, gate

    def combine(o1, o2, gate):
        o = o1 - lam_full.astype(o1.dtype) * o2
        o = rms_norm(o, g_sub) * (1.0 - lambda_init)
        return gated(o, gate)

    q, k, v, gate = project(h, True)
    q_c, k_c, v_c, gate_c = project(h_c, False)
    o1, o1_c = prefix_attention(q[:, :, :, 0:1], k[:, :, :, 0], v, q_c[:, :, :, 0:1], k_c[:, :, :, 0], v_c, scale, need_ctx)
    o2, o2_c = prefix_attention(q[:, :, :, 1:2], k[:, :, :, 1], v, q_c[:, :, :, 1:2], k_c[:, :, :, 1], v_c, scale, need_ctx)
    return combine(o1, o2, gate), (combine(o1_c, o2_c, gate_c) if need_ctx else None)


def qknorm_gqa_mixer(h, h_c, rows, need_ctx, w_in, g_q, g_k):
    cos, sin = axial_rope_tables(rows, C_HEAD)
    splits = [C_HEADS * C_HEAD, (C_HEADS + C_KV_HEADS) * C_HEAD, (C_HEADS + 2 * C_KV_HEADS) * C_HEAD]

    def project(t, rope):
        bsz, n = t.shape[:2]
        q, k, v, gate = jnp.split(t @ w_in, splits, axis=-1)
        q = rms_norm(q.reshape(bsz, n, C_HEADS, C_HEAD), g_q)
        k = rms_norm(k.reshape(bsz, n, C_KV_HEADS, C_HEAD), g_k)
        v = v.reshape(bsz, n, C_KV_HEADS, C_HEAD)
        if rope:
            q = apply_rope(q, cos, sin)
            k = apply_rope(k, cos, sin)
        q = q.reshape(bsz, n, C_KV_HEADS, C_HEADS // C_KV_HEADS, C_HEAD)
        return q, k, v, gate

    q, k, v, gate = project(h, True)
    q_c, k_c, v_c, gate_c = project(h_c, False)
    o, o_c = prefix_attention(q, k, v, q_c, k_c, v_c, C_HEAD ** -0.5, need_ctx)
    return gated(o, gate), (gated(o_c, gate_c) if need_ctx else None)


def swa_sink_mixer(h, h_c, rows, need_ctx, w_in, sinks):
    cos, sin = axial_rope_tables(rows, D_HEAD)
    splits = [D_HEADS * D_HEAD, (D_HEADS + D_KV_HEADS) * D_HEAD, (D_HEADS + 2 * D_KV_HEADS) * D_HEAD]
    scale = D_HEAD ** -0.5

    def project(t, rope):
        bsz, n = t.shape[:2]
        q, k, v, gate = jnp.split(t @ w_in, splits, axis=-1)
        q = q.reshape(bsz, n, D_HEADS, D_HEAD)
        k = k.reshape(bsz, n, D_KV_HEADS, D_HEAD)
        v = v.reshape(bsz, n, D_KV_HEADS, D_HEAD)
        if rope:
            q = apply_rope(q, cos, sin)
            k = apply_rope(k, cos, sin)
        q = q.reshape(bsz, n, D_KV_HEADS, D_HEADS // D_KV_HEADS, D_HEAD)
        return q, k, v, gate

    q, k, v, gate = project(h, True)
    q_c, k_c, v_c, gate_c = project(h_c, False)
    o = window_sink_attention(q, k, v, k_c, v_c, sinks, scale)
    o_c = gated(context_sink_attention(q_c, k_c, v_c, sinks, scale), gate_c) if need_ctx else None
    return gated(o, gate), o_c


def setup_inputs(seed: int = 0) -> dict:
    key = jax.random.key(seed)
    ks = iter(jax.random.split(key, 32))

    def nrm(shape, std):
        return jax.random.normal(next(ks), shape, jnp.float32) * std

    def gain(shape):
        return 1.0 + nrm(shape, 0.02)

    n_a = len(range(0, DEPTH, N_MIXERS))
    n_b = len(range(1, DEPTH, N_MIXERS))
    n_c = len(range(2, DEPTH, N_MIXERS))
    n_d = len(range(3, DEPTH, N_MIXERS))
    return {
        'x': nrm((BATCH, SEQ, D_MODEL), 1.0),
        'c': nrm((BATCH, D_MODEL), 1.0),
        'ctx': nrm((BATCH, CTX_LEN, D_MODEL), 1.0),
        'c_ctx': nrm((D_MODEL,), 1.0),
        'ada_w': nrm((DEPTH, D_MODEL, 3 * D_MODEL), 0.02),
        'ada_b': nrm((DEPTH, 3 * D_MODEL), 0.02),
        'out_w': nrm((DEPTH, WIDTH, D_MODEL), DEEPNORM_BETA * WIDTH ** -0.5),
        'ln_g': gain((DEPTH, D_MODEL)),
        'ln_b': nrm((DEPTH, D_MODEL), 0.02),
        'mla_w_in': nrm((n_a, D_MODEL, A_IN), D_MODEL ** -0.5),
        'mla_g_qa': gain((n_a, A_Q_LORA)),
        'mla_w_qb': nrm((n_a, A_Q_LORA, A_HEADS * (A_NOPE + A_ROPE)), A_Q_LORA ** -0.5),
        'mla_g_kva': gain((n_a, A_KV_LORA)),
        'mla_w_kvb': nrm((n_a, A_KV_LORA, A_HEADS * (A_NOPE + A_V)), A_KV_LORA ** -0.5),
        'diff_w_in': nrm((n_b, D_MODEL, B_IN), D_MODEL ** -0.5),
        'diff_lambda': nrm((n_b, 4, B_HEAD), 0.1),
        'diff_g_sub': gain((n_b, 2 * B_HEAD)),
        'gqa_w_in': nrm((n_c, D_MODEL, C_IN), D_MODEL ** -0.5),
        'gqa_g_q': gain((n_c, C_HEAD)),
        'gqa_g_k': gain((n_c, C_HEAD)),
        'swa_w_in': nrm((n_d, D_MODEL, D_IN), D_MODEL ** -0.5),
        'swa_sink': nrm((n_d, D_HEADS), 0.5),
    }


def reference(x, c, ctx, c_ctx, ada_w, ada_b, out_w, ln_g, ln_b,
              mla_w_in, mla_g_qa, mla_w_qb, mla_g_kva, mla_w_kvb,
              diff_w_in, diff_lambda, diff_g_sub,
              gqa_w_in, gqa_g_q, gqa_g_k,
              swa_w_in, swa_sink):
    ROWS = x.shape[1] // GRID_W
    for i in range(DEPTH):
        kind, j = i % N_MIXERS, i // N_MIXERS
        need_ctx = i < DEPTH - 1
        shift, scale, gate = adaln(c, ada_w[i], ada_b[i])
        shift_c, scale_c, gate_c = adaln(c_ctx, ada_w[i], ada_b[i])
        h = x * (1.0 + scale[:, None, :]) + shift[:, None, :]
        h_c = ctx * (1.0 + scale_c) + shift_c
        if kind == 0:
            o, o_c = mla_mixer(h, h_c, ROWS, need_ctx, mla_w_in[j], mla_g_qa[j], mla_w_qb[j], mla_g_kva[j], mla_w_kvb[j])
        elif kind == 1:
            o, o_c = diff_mixer(h, h_c, ROWS, need_ctx, i, diff_w_in[j], diff_lambda[j], diff_g_sub[j])
        elif kind == 2:
            o, o_c = qknorm_gqa_mixer(h, h_c, ROWS, need_ctx, gqa_w_in[j], gqa_g_q[j], gqa_g_k[j])
        else:
            o, o_c = swa_sink_mixer(h, h_c, ROWS, need_ctx, swa_w_in[j], swa_sink[j])
        x = layer_norm(DEEPNORM_ALPHA * x + gate[:, None, :] * (o @ out_w[i]), ln_g[i], ln_b[i])
        if need_ctx:
            ctx = layer_norm(DEEPNORM_ALPHA * ctx + gate_c * (o_c @ out_w[i]), ln_g[i], ln_b[i])
    return x
```

```cpp
#include <hip/hip_runtime.h>
#include <hip/hip_cooperative_groups.h>
#include <cstdio>
#include <cstdint>
namespace cg = cooperative_groups;

typedef unsigned short bf16_t;
using bf16x8 = __attribute__((ext_vector_type(8))) short;
using s16x4  = __attribute__((ext_vector_type(4))) short;
using f32x16 = __attribute__((ext_vector_type(16))) float;
using f32x4  = __attribute__((ext_vector_type(4))) float;
using u32x4  = __attribute__((ext_vector_type(4))) unsigned;
using u32x2  = __attribute__((ext_vector_type(2))) unsigned;

constexpr int DM = 1024, NBATCH = 2, SEQ = 16384, CTXL = 256, TPB = SEQ + CTXL, NROW = NBATCH * TPB;
constexpr int NTHR = 512;
constexpr float EPS = 1e-6f;
constexpr float ALPHA = 1.681792830507429f;
constexpr float LAMBDA_INIT = 0.35550906759096544f;
constexpr float LOG2E = 1.4426950408889634f;

constexpr size_t al256(size_t x) { return (x + 255) / 256 * 256; }
constexpr int NPAD0 = 1536, NPAD1 = 4096, NPAD2 = 2560, NPAD3 = 2304;
constexpr size_t WS_WIN0 = 0;
constexpr size_t WS_WIN1 = WS_WIN0 + (size_t)NPAD0 * 1024 * 2;
constexpr size_t WS_WIN2 = WS_WIN1 + (size_t)NPAD1 * 1024 * 2;
constexpr size_t WS_WIN3 = WS_WIN2 + (size_t)NPAD2 * 1024 * 2;
constexpr size_t WS_WOUT = WS_WIN3 + (size_t)NPAD3 * 1024 * 2;
constexpr size_t WS_WQB  = WS_WOUT + (size_t)4 * 1024 * 1024 * 2;
constexpr size_t WS_WKVB = WS_WQB + (size_t)1536 * 256 * 2;
constexpr size_t WS_MOD  = WS_WKVB + (size_t)2048 * 128 * 2;
constexpr size_t WS_ROPE = WS_MOD + (size_t)4 * 3 * 3072 * 4;
constexpr int ROPE32_OFF = 0, ROPE64_OFF = 256 * 8 * 2, ROPE128_OFF = ROPE64_OFF + 256 * 16 * 2, ROPE_TOTAL = ROPE128_OFF + 256 * 32 * 2;
constexpr size_t WS_MISC = WS_ROPE + (size_t)ROPE_TOTAL * 4;
constexpr size_t WS_BAR  = al256(WS_MISC + 256);
constexpr size_t WS_ABUF = al256(WS_BAR + 256);
constexpr size_t WS_X    = WS_ABUF + (size_t)NROW * 1024 * 2;
constexpr size_t WS_PROJ = WS_X + (size_t)NROW * 1024 * 4;
constexpr size_t WS_KV2  = WS_PROJ + (size_t)NROW * 1536 * 2;
constexpr size_t WS_END  = WS_PROJ + (size_t)NROW * 4096 * 2;

constexpr int LDS_BYTES = 143360;

struct P {
  const float *x, *c, *ctx, *c_ctx, *ada_w, *ada_b, *out_w, *ln_g, *ln_b;
  const float *mla_w_in, *mla_g_qa, *mla_w_qb, *mla_g_kva, *mla_w_kvb;
  const float *diff_w_in, *diff_lambda, *diff_g_sub;
  const float *gqa_w_in, *gqa_g_q, *gqa_g_k;
  const float *swa_w_in, *swa_sink;
  float* out; char* ws;
};

#define SBAR() __builtin_amdgcn_sched_barrier(0)
#define LAUNDER_V(x) asm volatile("" : "+v"(x))
__device__ __forceinline__ int crow(int r, int hi) { return (r & 3) + 8 * (r >> 2) + 4 * hi; }
__device__ __forceinline__ unsigned cvtpk(float lo, float hi) {
  unsigned r; asm volatile("v_cvt_pk_bf16_f32 %0, %1, %2" : "=v"(r) : "v"(lo), "v"(hi)); return r;
}
__device__ __forceinline__ float bf2f(short v) { return __uint_as_float(((unsigned)(unsigned short)v) << 16); }
__device__ __forceinline__ bf16_t f2bf(float f) { return (bf16_t)(cvtpk(f, f) & 0xffffu); }
__device__ __forceinline__ float silu_f(float v) { return v / (1.f + __expf(-v)); }

__device__ __forceinline__ void grid_barrier(unsigned* ctr, unsigned epoch) {
  asm volatile("s_waitcnt vmcnt(0) lgkmcnt(0)" ::: "memory");
  __syncthreads();
  if (threadIdx.x == 0) {
    __builtin_amdgcn_fence(__ATOMIC_RELEASE, "agent");
    asm volatile("s_waitcnt vmcnt(0)" ::: "memory");
    __hip_atomic_fetch_add(ctr, 1u, __ATOMIC_RELAXED, __HIP_MEMORY_SCOPE_AGENT);
    const unsigned target = epoch * gridDim.x;
    while (__hip_atomic_load(ctr, __ATOMIC_RELAXED, __HIP_MEMORY_SCOPE_AGENT) < target) __builtin_amdgcn_s_sleep(1);
    __builtin_amdgcn_fence(__ATOMIC_ACQUIRE, "agent");
    asm volatile("s_waitcnt vmcnt(0)" ::: "memory");
  }
  __syncthreads();
}

__device__ __forceinline__ void transpose_tile(const float* __restrict__ src, int K, int N, bf16_t* __restrict__ dst, const float* __restrict__ gain, int tk, int tn, float* tile) {
  int tid = threadIdx.x; LAUNDER_V(tid);
  {
    const int n = tid & 63, kb = tid >> 6;
#pragma unroll
    for (int i = 0; i < 8; ++i) {
      const int k = kb + 8 * i; const int gn = tn * 64 + n, gk = tk * 64 + k;
      float v = 0.f;
      if (gn < N) { v = src[(size_t)gk * N + gn]; if (gain) v *= gain[gk]; }
      tile[k * 65 + n] = v;
    }
  }
  __syncthreads();
  {
    const int kk = (tid & 31) * 2, nb = tid >> 5;
#pragma unroll
    for (int i = 0; i < 4; ++i) {
      const int nn = nb + 16 * i;
      const unsigned w = cvtpk(tile[kk * 65 + nn], tile[(kk + 1) * 65 + nn]);
      *(unsigned*)(dst + (size_t)(tn * 64 + nn) * K + tk * 64 + kk) = w;
    }
  }
  __syncthreads();
}

__device__ __forceinline__ void phase_prep(const P& p, char* lds) {
  int tid = threadIdx.x; LAUNDER_V(tid);
  float* tile = (float*)lds;
  constexpr int T0 = 16 * 24, T1 = 16 * 64, T2 = 16 * 40, T3 = 16 * 36, TO = 16 * 16, TQ = 4 * 24, TK = 2 * 32;
  constexpr int E0 = T0, E1 = E0 + T1, E2 = E1 + T2, E3 = E2 + T3, E4 = E3 + 4 * TO, E5 = E4 + TQ, E6 = E5 + TK;
  for (int t = blockIdx.x; t < E6; t += gridDim.x) {
    const float* src; int K, N, NP; bf16_t* dst; const float* gain = nullptr; int lt;
    if (t < E0)      { lt = t;      src = p.mla_w_in;  K = 1024; N = 1440; NP = NPAD0; dst = (bf16_t*)(p.ws + WS_WIN0); }
    else if (t < E1) { lt = t - E0; src = p.diff_w_in; K = 1024; N = 4096; NP = NPAD1; dst = (bf16_t*)(p.ws + WS_WIN1); }
    else if (t < E2) { lt = t - E1; src = p.gqa_w_in;  K = 1024; N = 2560; NP = NPAD2; dst = (bf16_t*)(p.ws + WS_WIN2); }
    else if (t < E3) { lt = t - E2; src = p.swa_w_in;  K = 1024; N = 2304; NP = NPAD3; dst = (bf16_t*)(p.ws + WS_WIN3); }
    else if (t < E4) { lt = t - E3; const int l = lt / TO; lt -= l * TO; src = p.out_w + (size_t)l * 1024 * 1024; K = 1024; N = 1024; NP = 1024; dst = (bf16_t*)(p.ws + WS_WOUT) + (size_t)l * 1024 * 1024; }
    else if (t < E5) { lt = t - E4; src = p.mla_w_qb;  K = 256; N = 1536; NP = 1536; dst = (bf16_t*)(p.ws + WS_WQB); gain = p.mla_g_qa; }
    else             { lt = t - E5; src = p.mla_w_kvb; K = 128; N = 2048; NP = 2048; dst = (bf16_t*)(p.ws + WS_WKVB); gain = p.mla_g_kva; }
    const int ntn = NP / 64; const int tk = lt / ntn, tn = lt % ntn;
    transpose_tile(src, K, N, dst, gain, tk, tn, tile);
  }
  {
    float* sv = (float*)lds;
    float* red = (float*)lds + 3072;
    for (int i = tid; i < 3072; i += NTHR) {
      const int v = i >> 10, k = i & 1023;
      const float cv = v == 0 ? p.c[k] : v == 1 ? p.c[1024 + k] : p.c_ctx[k];
      sv[i] = silu_f(cv);
    }
    __syncthreads();
    for (int it = blockIdx.x; it < 4 * 48; it += gridDim.x) {
      const int l = it / 48, n0 = (it % 48) * 64;
      const int n = tid & 63, kc = tid >> 6;
      const float* w = p.ada_w + (size_t)l * 1024 * 3072 + (size_t)(kc * 128) * 3072 + n0 + n;
      float a0 = 0.f, a1 = 0.f, a2 = 0.f;
#pragma unroll 8
      for (int k = 0; k < 128; ++k) {
        const float wv = w[(size_t)k * 3072];
        a0 += sv[kc * 128 + k] * wv; a1 += sv[1024 + kc * 128 + k] * wv; a2 += sv[2048 + kc * 128 + k] * wv;
      }
      red[(kc * 64 + n) * 3 + 0] = a0; red[(kc * 64 + n) * 3 + 1] = a1; red[(kc * 64 + n) * 3 + 2] = a2;
      __syncthreads();
      if (tid < 192) {
        const int v = tid >> 6, nn = tid & 63; float s = 0.f;
#pragma unroll
        for (int q = 0; q < 8; ++q) s += red[(q * 64 + nn) * 3 + v];
        s += p.ada_b[l * 3072 + n0 + nn];
        ((float*)(p.ws + WS_MOD))[(l * 3 + v) * 3072 + n0 + nn] = s;
      }
      __syncthreads();
    }
  }
  {
    float* rt = (float*)(p.ws + WS_ROPE);
    const int gt = blockIdx.x * NTHR + tid;
    for (int i = gt; i < 256 * 56; i += gridDim.x * NTHR) {
      const int pos = i / 56, j = i % 56;
      int nf, f, off;
      if (j < 8) { nf = 8; f = j; off = ROPE32_OFF; } else if (j < 24) { nf = 16; f = j - 8; off = ROPE64_OFF; } else { nf = 32; f = j - 24; off = ROPE128_OFF; }
      const float inv = exp2f(-(float)f / (float)nf * 13.287712379549449f);
      const float ang = (float)pos * inv;
      const float kq = rintf(ang * 0.15915494309189535f);
      float r = fmaf(-kq, 6.28318548202514648f, ang); r = fmaf(-kq, -1.7484555e-07f, r);
      rt[off + pos * nf + f] = cosf(r); rt[off + 256 * nf + pos * nf + f] = sinf(r);
    }
    if (blockIdx.x == 0 && tid < 64) {
      const float* lm = p.diff_lambda;
      float s1 = lm[tid] * lm[64 + tid], s2 = lm[128 + tid] * lm[192 + tid];
#pragma unroll
      for (int o = 32; o >= 1; o >>= 1) { s1 += __shfl_xor(s1, o); s2 += __shfl_xor(s2, o); }
      if (tid == 0) ((float*)(p.ws + WS_MISC))[0] = __expf(s1) - __expf(s2) + LAMBDA_INIT;
    }
  }
}

__device__ __forceinline__ void phase_h0(const P& p) {
  const float* mod = (const float*)(p.ws + WS_MOD);
  bf16_t* hb = (bf16_t*)(p.ws + WS_ABUF);
  const size_t total = (size_t)NROW * 128;
  int tid = threadIdx.x; LAUNDER_V(tid);
  for (size_t i = (size_t)blockIdx.x * NTHR + tid; i < total; i += (size_t)gridDim.x * NTHR) {
    const int row = (int)(i >> 7), c8 = (int)(i & 127) * 8;
    const int b = row / TPB, t = row % TPB;
    const float* src; int v;
    if (t < SEQ) { src = p.x + ((size_t)b * SEQ + t) * 1024; v = b; } else { src = p.ctx + ((size_t)b * CTXL + (t - SEQ)) * 1024; v = 2; }
    const float* sh = mod + v * 3072 + c8; const float* sc = sh + 1024;
    const f32x4 x0 = *(const f32x4*)(src + c8), x1 = *(const f32x4*)(src + c8 + 4);
    const f32x4 s0 = *(const f32x4*)sc, s1 = *(const f32x4*)(sc + 4), h0 = *(const f32x4*)sh, h1 = *(const f32x4*)(sh + 4);
    u32x4 w;
    w.x = cvtpk(x0[0] * (1.f + s0[0]) + h0[0], x0[1] * (1.f + s0[1]) + h0[1]);
    w.y = cvtpk(x0[2] * (1.f + s0[2]) + h0[2], x0[3] * (1.f + s0[3]) + h0[3]);
    w.z = cvtpk(x1[0] * (1.f + s1[0]) + h1[0], x1[1] * (1.f + s1[1]) + h1[1]);
    w.w = cvtpk(x1[2] * (1.f + s1[2]) + h1[2], x1[3] * (1.f + s1[3]) + h1[3]);
    *(u32x4*)(hb + (size_t)row * 1024 + c8) = w;
  }
}

template <int MB, class Epi>
__device__ __forceinline__ void gemm_tile(const bf16_t* __restrict__ A, int lda, const bf16_t* __restrict__ Bt, int ldb, int K, const Epi& epi, char* lds) {
  int tid = threadIdx.x; LAUNDER_V(tid);
  const int wid = tid >> 6, lane = tid & 63, r32 = lane & 31, hi = lane >> 5;
  const int m0 = (wid >> 2) * (MB * 32), n0 = (wid & 3) * 64;
  const int sc = tid & 7, sr = tid >> 3;
  const unsigned aofs = (unsigned)(sr * lda + sc * 8) * 2u, bofs = (unsigned)(sr * ldb + sc * 8) * 2u;
  const int sw = sr * 128 + ((sc ^ ((sr >> 1) & 7)) << 4);
  const int xr = (r32 >> 1) & 7;
  const int aoff = (m0 + r32) * 128, boff = 32768 + (n0 + r32) * 128;
  const int co0 = ((0 + hi) ^ xr) << 4, co1 = ((2 + hi) ^ xr) << 4, co2 = ((4 + hi) ^ xr) << 4, co3 = ((6 + hi) ^ xr) << 4;
  f32x16 acc[MB][2];
#pragma unroll
  for (int i = 0; i < MB; ++i) { acc[i][0] = f32x16{}; acc[i][1] = f32x16{}; }
  u32x4 ra[MB], rb[4];
  const int nk = K >> 6;
#define GLOAD(kt) do { const char* ab_ = (const char*)A + (size_t)(kt) * 128; const char* bb_ = (const char*)Bt + (size_t)(kt) * 128; \
    _Pragma("unroll") for (int i = 0; i < MB; ++i) ra[i] = *(const u32x4*)(ab_ + (size_t)(i * 64) * lda * 2 + aofs); \
    _Pragma("unroll") for (int i = 0; i < 4; ++i) rb[i] = *(const u32x4*)(bb_ + (size_t)(i * 64) * ldb * 2 + bofs); } while (0)
#define GWRITE(buf) do { _Pragma("unroll") for (int i = 0; i < MB; ++i) *(u32x4*)(lds + (buf) * 65536 + sw + i * 8192) = ra[i]; \
    _Pragma("unroll") for (int i = 0; i < 4; ++i) *(u32x4*)(lds + (buf) * 65536 + 32768 + sw + i * 8192) = rb[i]; } while (0)
#define FLOAD(fa, fb, co) do { _Pragma("unroll") for (int mb = 0; mb < MB; ++mb) fa[mb] = *(const bf16x8*)(base + aoff + mb * 4096 + (co)); \
    _Pragma("unroll") for (int nb = 0; nb < 2; ++nb) fb[nb] = *(const bf16x8*)(base + boff + nb * 4096 + (co)); } while (0)
#define FMMA(fa, fb) do { _Pragma("unroll") for (int mb = 0; mb < MB; ++mb) _Pragma("unroll") for (int nb = 0; nb < 2; ++nb) \
    acc[mb][nb] = __builtin_amdgcn_mfma_f32_32x32x16_bf16(fa[mb], fb[nb], acc[mb][nb], 0, 0, 0); } while (0)
  GLOAD(0); GWRITE(0); if (nk > 1) GLOAD(1); __syncthreads();
  for (int kt = 0; kt < nk; ++kt) {
    const int buf = kt & 1;
    const char* base = lds + buf * 65536;
    bf16x8 a0[MB], b0[2], a1[MB], b1[2];
    FLOAD(a0, b0, co0); SBAR();
    if (kt + 1 < nk) { GWRITE(buf ^ 1); if (kt + 2 < nk) GLOAD(kt + 2); } SBAR();
    FLOAD(a1, b1, co1); FMMA(a0, b0); SBAR();
    FLOAD(a0, b0, co2); FMMA(a1, b1); SBAR();
    FLOAD(a1, b1, co3); FMMA(a0, b0); SBAR();
    FMMA(a1, b1); SBAR();
    __syncthreads();
  }
#undef GLOAD
#undef GWRITE
#undef FLOAD
#undef FMMA
  epi.template operator()<MB>(acc, m0, n0, r32, hi);
}

struct EpiBf16 {
  bf16_t* O; int ldo; const float* rs;
  template <int MB> __device__ __forceinline__ void operator()(const f32x16 (&acc)[MB][2], int m0, int n0, int r32, int hi) const {
    unsigned base = (unsigned)((m0 + 4 * hi) * ldo + n0 + r32) * 2u; LAUNDER_V(base);
    int rbase = m0 + 4 * hi; LAUNDER_V(rbase);
    char* Ob = (char*)O;
#pragma unroll
    for (int mb = 0; mb < MB; ++mb)
#pragma unroll
      for (int r = 0; r < 16; ++r) {
        const int rr = mb * 32 + (r & 3) + 8 * (r >> 2);
        const float s = rs ? rs[rbase + rr] : 1.f;
        const unsigned off = base + (unsigned)(rr * ldo) * 2u;
        *(bf16_t*)(Ob + off) = f2bf(acc[mb][0][r] * s);
        *(bf16_t*)(Ob + off + 64) = f2bf(acc[mb][1][r] * s);
        if ((r & 7) == 7) SBAR();
      }
  }
};
struct EpiOut {
  const float* res; float* out; const float* g;
  template <int MB> __device__ __forceinline__ void operator()(const f32x16 (&acc)[MB][2], int m0, int n0, int r32, int hi) const {
    const float g0 = g[n0 + r32], g1 = g[n0 + 32 + r32];
    unsigned base = (unsigned)((m0 + 4 * hi) * 1024 + n0 + r32) * 4u; LAUNDER_V(base);
    const char* rb = (const char*)res; char* ob = (char*)out;
#pragma unroll
    for (int mb = 0; mb < MB; ++mb)
#pragma unroll
      for (int r = 0; r < 16; ++r) {
        const unsigned off = base + (unsigned)((mb * 32 + (r & 3) + 8 * (r >> 2)) * 4096);
        const float x0 = *(const float*)(rb + off), x1 = *(const float*)(rb + off + 128);
        *(float*)(ob + off) = ALPHA * x0 + g0 * acc[mb][0][r];
        *(float*)(ob + off + 128) = ALPHA * x1 + g1 * acc[mb][1][r];
        if ((r & 3) == 3) SBAR();
      }
  }
};

namespace g8 {
constexpr int BK = 64, HALF = 128, HT = HALF * BK;
__device__ __forceinline__ int lds_byte(int r, int c) { const int st = (r >> 4) * 2 + (c >> 5), rr = r & 15, cc = c & 31, ob = rr * 64 + cc * 2; return st * 1024 + (ob ^ (((ob >> 9) & 1) << 5)); }
__device__ __forceinline__ void stage_rc(int b, int& R, int& C) { const int st = b / 1024, sb = b % 1024, swz = sb ^ (((sb >> 9) & 1) << 5); R = (st >> 1) * 16 + swz / 64; C = (st & 1) * 32 + (swz % 64) / 2; }
template <class Epi>
__device__ __forceinline__ void gemm_tile8(const bf16_t* __restrict__ A, const bf16_t* __restrict__ Bt, int K, const Epi& epi, char* lds) {
  bf16_t* shm = (bf16_t*)lds;
  int tid = threadIdx.x; LAUNDER_V(tid);
#define SA(b, h) (shm + ((b) * 2 + (h)) * HT)
#define SB(b, h) (shm + (4 + (b) * 2 + (h)) * HT)
#define STAGE(Pp, BASE, br, kt) do { const long g_ = (long)(br) * K + (long)(kt) * BK; \
    _Pragma("unroll") for (int i_ = 0; i_ < 2; ++i_) { const int b_ = tid * 16 + i_ * 8192; int r_, c_; stage_rc(b_, r_, c_); \
      __builtin_amdgcn_global_load_lds((const unsigned*)(BASE + g_ + (long)r_ * K + c_), (unsigned*)((char*)(Pp) + b_), 16, 0, 0); } } while (0)
#define LDA(dst, b, h) _Pragma("unroll") for (int m = 0; m < 4; ++m) _Pragma("unroll") for (int k = 0; k < 2; ++k) \
    dst[m][k] = *reinterpret_cast<const bf16x8*>((char*)SA(b, h) + lds_byte(wr * 64 + m * 16 + fr, k * 32 + fq * 8))
#define LDB(dst, b, h) _Pragma("unroll") for (int n = 0; n < 2; ++n) _Pragma("unroll") for (int k = 0; k < 2; ++k) \
    dst[n][k] = *reinterpret_cast<const bf16x8*>((char*)SB(b, h) + lds_byte(wc * 32 + n * 16 + fr, k * 32 + fq * 8))
#define MMA(ai, bj, Af, Bf) do { __builtin_amdgcn_s_setprio(1); \
    _Pragma("unroll") for (int m = 0; m < 4; ++m) _Pragma("unroll") for (int n = 0; n < 2; ++n) _Pragma("unroll") for (int k = 0; k < 2; ++k) \
      acc[ai][bj][m][n] = __builtin_amdgcn_mfma_f32_16x16x32_bf16(Bf[n][k], Af[m][k], acc[ai][bj][m][n], 0, 0, 0); \
    __builtin_amdgcn_s_setprio(0); } while (0)
#define WAIT_V(n) asm volatile("s_waitcnt vmcnt(" #n ")" ::: "memory")
#define WAIT_L(n) asm volatile("s_waitcnt lgkmcnt(" #n ")" ::: "memory")
#define BAR __builtin_amdgcn_s_barrier()
#define SCHED __builtin_amdgcn_sched_barrier(0)
  const int wid = tid >> 6, lane = tid & 63, wr = wid >> 2, wc = wid & 3, fr = lane & 15, fq = lane >> 4;
  f32x4 acc[2][2][4][2];
#pragma unroll
  for (int a_ = 0; a_ < 2; ++a_)
#pragma unroll
    for (int b_ = 0; b_ < 2; ++b_)
#pragma unroll
      for (int m = 0; m < 4; ++m) { acc[a_][b_][m][0] = f32x4{0.f, 0.f, 0.f, 0.f}; acc[a_][b_][m][1] = f32x4{0.f, 0.f, 0.f, 0.f}; }
  bf16x8 At[4][2], B0[2][2], B1[2][2];
  const int nt = K / BK;
  WAIT_V(0); __syncthreads();
  STAGE(SB(0, 0), Bt, 0, 0); STAGE(SA(0, 0), A, 0, 0);
  STAGE(SB(0, 1), Bt, HALF, 0); STAGE(SA(0, 1), A, HALF, 0);
  if (wr == 1) BAR;
  WAIT_V(4); BAR;
  STAGE(SB(1, 0), Bt, 0, 1); STAGE(SA(1, 0), A, 0, 1); STAGE(SB(1, 1), Bt, HALF, 1);
  WAIT_V(6); BAR;
  for (int t = 0; t < nt - 2; t += 2) {
    LDB(B0, 0, 0); SCHED; LDA(At, 0, 0); STAGE(SA(1, 1), A, HALF, t + 1);
    WAIT_L(8); BAR; WAIT_L(0); MMA(0, 0, At, B0); BAR; SCHED;
    LDB(B1, 0, 1); STAGE(SB(0, 0), Bt, 0, t + 2);
    BAR; WAIT_L(0); MMA(0, 1, At, B1); BAR;
    LDA(At, 0, 1); STAGE(SA(0, 0), A, 0, t + 2);
    BAR; WAIT_L(0); MMA(1, 0, At, B0); BAR; SCHED;
    STAGE(SB(0, 1), Bt, HALF, t + 2);
    WAIT_V(6); BAR; MMA(1, 1, At, B1); BAR;
    LDB(B0, 1, 0); SCHED; LDA(At, 1, 0); STAGE(SA(0, 1), A, HALF, t + 2);
    WAIT_L(8); BAR; WAIT_L(0); MMA(0, 0, At, B0); BAR; SCHED;
    LDB(B1, 1, 1); STAGE(SB(1, 0), Bt, 0, t + 3);
    BAR; WAIT_L(0); MMA(0, 1, At, B1); BAR;
    LDA(At, 1, 1); STAGE(SA(1, 0), A, 0, t + 3);
    BAR; WAIT_L(0); MMA(1, 0, At, B0); BAR; SCHED;
    STAGE(SB(1, 1), Bt, HALF, t + 3);
    WAIT_V(6); BAR; MMA(1, 1, At, B1); BAR;
  }
  { LDB(B0, 0, 0); LDA(At, 0, 0); STAGE(SA(1, 1), A, HALF, nt - 1);
    BAR; WAIT_L(0); MMA(0, 0, At, B0); BAR;
    LDB(B1, 0, 1); BAR; WAIT_L(0); MMA(0, 1, At, B1); BAR;
    LDA(At, 0, 1); WAIT_V(4); BAR; WAIT_L(0); MMA(1, 0, At, B0); MMA(1, 1, At, B1); BAR; }
  { LDB(B0, 1, 0); LDA(At, 1, 0); WAIT_V(2); BAR; WAIT_L(0); MMA(0, 0, At, B0); BAR;
    LDB(B1, 1, 1); WAIT_V(0); BAR; WAIT_L(0); MMA(0, 1, At, B1); BAR;
    LDA(At, 1, 1); BAR; WAIT_L(0); MMA(1, 0, At, B0); MMA(1, 1, At, B1); BAR; }
  if (wr == 0) BAR;
#undef SA
#undef SB
#undef STAGE
#undef LDA
#undef LDB
#undef MMA
#undef WAIT_V
#undef WAIT_L
#undef BAR
#undef SCHED
  epi(acc, wr, wc, fr, fq);
}
struct EpiBf16 {
  bf16_t* O; int ldo;
  __device__ __forceinline__ void operator()(const f32x4 (&acc)[2][2][4][2], int wr, int wc, int fr, int fq) const {
    unsigned base = (unsigned)((wr * 64 + fr) * ldo + wc * 32 + fq * 4) * 2u; LAUNDER_V(base);
    char* Ob = (char*)O;
#pragma unroll
    for (int ai = 0; ai < 2; ++ai)
#pragma unroll
      for (int m = 0; m < 4; ++m) {
        const unsigned ro = base + (unsigned)((ai * 128 + m * 16) * ldo) * 2u;
#pragma unroll
        for (int bj = 0; bj < 2; ++bj)
#pragma unroll
          for (int n = 0; n < 2; ++n) {
            const f32x4 v = acc[ai][bj][m][n];
            u32x2 w; w.x = cvtpk(v[0], v[1]); w.y = cvtpk(v[2], v[3]);
            *(u32x2*)(Ob + ro + (bj * 128 + n * 16) * 2) = w;
          }
        SBAR();
      }
  }
};
struct EpiOut {
  const float* res; float* out; const float* g;
  __device__ __forceinline__ void operator()(const f32x4 (&acc)[2][2][4][2], int wr, int wc, int fr, int fq) const {
    unsigned base = (unsigned)((wr * 64 + fr) * 1024 + wc * 32 + fq * 4) * 4u; LAUNDER_V(base);
    const char* rb = (const char*)res; char* ob = (char*)out;
    f32x4 gv[2][2];
#pragma unroll
    for (int bj = 0; bj < 2; ++bj)
#pragma unroll
      for (int n = 0; n < 2; ++n) gv[bj][n] = *(const f32x4*)(g + bj * 128 + wc * 32 + n * 16 + fq * 4);
#pragma unroll
    for (int ai = 0; ai < 2; ++ai)
#pragma unroll
      for (int m = 0; m < 4; ++m) {
        const unsigned ro = base + (unsigned)((ai * 128 + m * 16) * 4096);
#pragma unroll
        for (int bj = 0; bj < 2; ++bj)
#pragma unroll
          for (int n = 0; n < 2; ++n) {
            const unsigned o_ = ro + (bj * 128 + n * 16) * 4;
            const f32x4 x = *(const f32x4*)(rb + o_);
            *(f32x4*)(ob + o_) = x * ALPHA + gv[bj][n] * acc[ai][bj][m][n];
          }
        SBAR();
      }
  }
};
}

__device__ __forceinline__ void tile_order(int L, int nM, int nN, int& pm, int& pn) {
  const int nwg = nM * nN, q = nwg >> 3, r = nwg & 7, xcd = L & 7, off = L >> 3;
  const int wgid = (xcd < r ? xcd * (q + 1) : r * (q + 1) + (xcd - r) * q) + off;
  const int nig = 8 * nN, gid = wgid / nig, fm = gid * 8, gsz = (nM - fm) < 8 ? (nM - fm) : 8;
  pm = fm + ((wgid % nig) % gsz); pn = (wgid % nig) / gsz;
}
__device__ __forceinline__ void phase_gemm1(const P& p, int layer, char* lds) {
  const int npad = layer == 0 ? NPAD0 : layer == 1 ? NPAD1 : layer == 2 ? NPAD2 : NPAD3;
  const size_t woff = layer == 0 ? WS_WIN0 : layer == 1 ? WS_WIN1 : layer == 2 ? WS_WIN2 : WS_WIN3;
  const bf16_t* A = (const bf16_t*)(p.ws + WS_ABUF);
  const bf16_t* W = (const bf16_t*)(p.ws + woff);
  bf16_t* O = (bf16_t*)(p.ws + WS_PROJ);
  const int nN = npad / 256, nt = 128 * nN;
  for (int t = blockIdx.x; t < nt; t += gridDim.x) {
    int pl, pn; tile_order(t, 128, nN, pl, pn); const int pm = pl + pl / 64;
    g8::EpiBf16 e{O + (size_t)pm * 256 * npad + pn * 256, npad};
    g8::gemm_tile8(A + (size_t)pm * 256 * 1024, W + (size_t)pn * 256 * 1024, 1024, e, lds);
  }
  for (int u = gridDim.x - 1 - blockIdx.x; u < 8 * nN; u += gridDim.x) {
    const int q = u / nN, pn = u % nN; const size_t row0 = (size_t)(q >> 2) * TPB + SEQ + (q & 3) * 64;
    EpiBf16 e{O + row0 * npad + pn * 256, npad, nullptr};
    gemm_tile<1>(A + row0 * 1024, 1024, W + (size_t)pn * 256 * 1024, 1024, 1024, e, lds);
  }
}

__device__ __forceinline__ void phase_gemm2(const P& p, char* lds) {
  const bf16_t* P1 = (const bf16_t*)(p.ws + WS_PROJ);
  float* rs = (float*)(lds + 131072);
  int tid = threadIdx.x; LAUNDER_V(tid);
  for (int t = blockIdx.x; t < 130 * 14; t += gridDim.x) {
    const int pm = t / 14, j = t % 14;
    const bool isq = j < 6; const int pn = isq ? j : j - 6;
    const int KK = isq ? 256 : 128, acol = isq ? 0 : 256;
    const bf16_t* A = P1 + (size_t)pm * 256 * 1536 + acol;
    {
      const int r = tid >> 1, half = tid & 1;
      const bf16_t* ap = A + (size_t)r * 1536 + half * (KK / 2);
      float ss = 0.f;
      for (int i = 0; i < KK / 16; ++i) { const bf16x8 v = *(const bf16x8*)(ap + i * 8);
#pragma unroll
        for (int e = 0; e < 8; ++e) { const float f = bf2f(v[e]); ss += f * f; } }
      ss += __shfl_xor(ss, 1);
      if (!half) rs[r] = rsqrtf(ss / (float)KK + EPS);
    }
    __syncthreads();
    if (isq) {
      EpiBf16 e{(bf16_t*)(p.ws + WS_X) + (size_t)pm * 256 * 1536 + pn * 256, 1536, rs};
      gemm_tile<4>(A, 1536, (const bf16_t*)(p.ws + WS_WQB) + (size_t)pn * 256 * 256, 256, 256, e, lds);
    } else {
      EpiBf16 e{(bf16_t*)(p.ws + WS_KV2) + (size_t)pm * 256 * 2048 + pn * 256, 2048, rs};
      gemm_tile<4>(A, 1536, (const bf16_t*)(p.ws + WS_WKVB) + (size_t)pn * 256 * 128, 128, 128, e, lds);
    }
    __syncthreads();
  }
}

__device__ __forceinline__ void phase_outproj(const P& p, int layer, char* lds) {
  const bf16_t* A = (const bf16_t*)(p.ws + WS_ABUF);
  const bf16_t* W = (const bf16_t*)(p.ws + WS_WOUT) + (size_t)layer * 1024 * 1024;
  float* X = (float*)(p.ws + WS_X);
  const float* mod = (const float*)(p.ws + WS_MOD) + layer * 3 * 3072;
  for (int t = blockIdx.x; t < 128 * 4; t += gridDim.x) {
    int pl, pn; tile_order(t, 128, 4, pl, pn); const int pm = pl + pl / 64; const int b = pm / 65, lt = pm % 65;
    const float* res = layer == 0 ? p.x + ((size_t)b * SEQ + lt * 256) * 1024 : X + (size_t)pm * 256 * 1024;
    g8::EpiOut e{res + pn * 256, X + (size_t)pm * 256 * 1024 + pn * 256, mod + b * 3072 + 2048 + pn * 256};
    g8::gemm_tile8(A + (size_t)pm * 256 * 1024, W + (size_t)pn * 256 * 1024, 1024, e, lds);
  }
  if (layer < 3) {
    for (int u = blockIdx.x; u < 32; u += gridDim.x) {
      const int q = u >> 2, pn = u & 3; const int b = q >> 2; const size_t row0 = (size_t)b * TPB + SEQ + (q & 3) * 64;
      const float* res = layer == 0 ? p.ctx + ((size_t)b * CTXL + (q & 3) * 64) * 1024 : X + row0 * 1024;
      EpiOut e{res + pn * 256, X + row0 * 1024 + pn * 256, mod + 2 * 3072 + 2048 + pn * 256};
      gemm_tile<1>(A + row0 * 1024, 1024, W + (size_t)pn * 256 * 1024, 1024, 1024, e, lds);
    }
  }
}

__device__ __forceinline__ void phase_ln(const P& p, int layer) {
  float* X = (float*)(p.ws + WS_X);
  bf16_t* hb = (bf16_t*)(p.ws + WS_ABUF);
  const float* g = p.ln_g + layer * 1024; const float* bb = p.ln_b + layer * 1024;
  const float* modn = (const float*)(p.ws + WS_MOD) + (layer + 1) * 3 * 3072;
  const bool last = layer == 3;
  int tid = threadIdx.x; LAUNDER_V(tid);
  const int wid = tid >> 6, lane = tid & 63;
  for (int row = blockIdx.x * 8 + wid; row < NROW; row += gridDim.x * 8) {
    const int b = row / TPB, t = row % TPB;
    if (last && t >= SEQ) continue;
    float* xr = X + (size_t)row * 1024;
    f32x4 v[4]; float s = 0.f;
#pragma unroll
    for (int j = 0; j < 4; ++j) { v[j] = *(const f32x4*)(xr + j * 256 + lane * 4); s += (v[j][0] + v[j][1]) + (v[j][2] + v[j][3]); }
#pragma unroll
    for (int o = 32; o >= 1; o >>= 1) s += __shfl_xor(s, o);
    const float mean = s * (1.f / 1024.f); float q = 0.f;
#pragma unroll
    for (int j = 0; j < 4; ++j) { v[j] = v[j] - mean; q += (v[j][0] * v[j][0] + v[j][1] * v[j][1]) + (v[j][2] * v[j][2] + v[j][3] * v[j][3]); }
#pragma unroll
    for (int o = 32; o >= 1; o >>= 1) q += __shfl_xor(q, o);
    const float rstd = rsqrtf(q * (1.f / 1024.f) + EPS);
    const int vsel = t < SEQ ? b : 2;
    float* dst = last ? p.out + ((size_t)b * SEQ + t) * 1024 : xr;
#pragma unroll
    for (int j = 0; j < 4; ++j) {
      const int col = j * 256 + lane * 4;
      const f32x4 gg = *(const f32x4*)(g + col), be = *(const f32x4*)(bb + col);
      f32x4 y = v[j] * rstd * gg + be;
      *(f32x4*)(dst + col) = y;
      if (!last) {
        const f32x4 sh = *(const f32x4*)(modn + vsel * 3072 + col), sc = *(const f32x4*)(modn + vsel * 3072 + 1024 + col);
        u32x2 w; w.x = cvtpk(y[0] * (1.f + sc[0]) + sh[0], y[1] * (1.f + sc[1]) + sh[1]); w.y = cvtpk(y[2] * (1.f + sc[2]) + sh[2], y[3] * (1.f + sc[3]) + sh[3]);
        *(u32x2*)(hb + (size_t)row * 1024 + col) = w;
      }
    }
  }
}

__device__ __forceinline__ void unpack8(bf16x8 v, float (&f)[8]) {
#pragma unroll
  for (int e = 0; e < 8; ++e) f[e] = bf2f(v[e]);
}
__device__ __forceinline__ bf16x8 pack8(const float (&f)[8]) {
  u32x4 w = {cvtpk(f[0], f[1]), cvtpk(f[2], f[3]), cvtpk(f[4], f[5]), cvtpk(f[6], f[7])}; return *reinterpret_cast<bf16x8*>(&w);
}
__device__ __forceinline__ void rope8f(float (&x1)[8], float (&x2)[8], const float* cs, const float* sn) {
  const f32x4 c0 = *(const f32x4*)cs, c1 = *(const f32x4*)(cs + 4), s0 = *(const f32x4*)sn, s1 = *(const f32x4*)(sn + 4);
#pragma unroll
  for (int e = 0; e < 8; ++e) {
    const float c = e < 4 ? c0[e & 3] : c1[e & 3], s = e < 4 ? s0[e & 3] : s1[e & 3];
    const float a = x1[e], b = x2[e];
    x1[e] = a * c - b * s; x2[e] = b * c + a * s;
  }
}
__device__ __forceinline__ void rope8(bf16x8& a, bf16x8& b, const float* cs, const float* sn) {
  float x1[8], x2[8]; unpack8(a, x1); unpack8(b, x2); rope8f(x1, x2, cs, sn); a = pack8(x1); b = pack8(x2);
}

template <int KIND>
__device__ __forceinline__ void phase_kfix(const P& p) {
  constexpr int HD = KIND == 0 ? 32 : KIND == 2 ? 128 : 64;
  constexpr int UPR = KIND == 0 ? 1 : KIND == 1 ? 16 : 2;
  constexpr int G = HD / 16, NF = HD / 4;
  constexpr int LD = KIND == 0 ? NPAD0 : KIND == 1 ? NPAD1 : KIND == 2 ? NPAD2 : NPAD3;
  constexpr int BASE = KIND == 0 ? 384 : 1024;
  constexpr int ROFF = KIND == 0 ? ROPE32_OFF : KIND == 2 ? ROPE128_OFF : ROPE64_OFF;
  bf16_t* proj = (bf16_t*)(p.ws + WS_PROJ);
  const float* rt = (const float*)(p.ws + WS_ROPE) + ROFF;
  const size_t total = (size_t)NROW * UPR * G;
  int tid = threadIdx.x; LAUNDER_V(tid);
  for (size_t i = (size_t)blockIdx.x * NTHR + tid; i < total; i += (size_t)gridDim.x * NTHR) {
    const int sub = (int)(i % G); const size_t u = i / G; const int head = (int)(u % UPR); const int row = (int)(u / UPR);
    const int t = row % TPB; const bool latent = t < SEQ;
    if (KIND != 2 && !latent) continue;
    bf16_t* ptr = proj + (size_t)row * LD + BASE + head * HD + sub * 8;
    float x1[8], x2[8];
    unpack8(*(const bf16x8*)ptr, x1); unpack8(*(const bf16x8*)(ptr + HD / 2), x2);
    if (KIND == 2) {
      float ss = 0.f;
#pragma unroll
      for (int e = 0; e < 8; ++e) ss += x1[e] * x1[e] + x2[e] * x2[e];
      ss += __shfl_xor(ss, 1); ss += __shfl_xor(ss, 2); ss += __shfl_xor(ss, 4);
      const float rstd = rsqrtf(ss * (1.f / 128.f) + EPS);
#pragma unroll
      for (int e = 0; e < 8; ++e) { x1[e] *= rstd * p.gqa_g_k[sub * 8 + e]; x2[e] *= rstd * p.gqa_g_k[64 + sub * 8 + e]; }
    }
    if (latent) {
      const bool isrow = sub * 8 < NF; const int f0 = isrow ? sub * 8 : sub * 8 - NF; const int pos = isrow ? (t >> 6) : (t & 63);
      rope8f(x1, x2, rt + pos * NF + f0, rt + 256 * NF + pos * NF + f0);
    }
    *(bf16x8*)ptr = pack8(x1); *(bf16x8*)(ptr + HD / 2) = pack8(x2);
  }
}

template <int NCB> __device__ __forceinline__ int v_st(int k, int c) { const int kk = k;     return ((kk >> 3) * NCB + (c >> 5)) * 512 + ((kk & 7) * 32 + (c & 31)) * 2; }
__device__ __forceinline__ int v_rd_base(int lane) { return ((lane & 3) << 3) | (((lane >> 2) & 3) << 6) | (((lane >> 4) & 1) << 5) | (((lane >> 5) & 1) << 8); }
template <int OFF> __device__ __forceinline__ s16x4 tr_read(int vb) {
  s16x4 r; asm volatile("ds_read_b64_tr_b16 %0, %1 offset:%2" : "=&v"(r) : "v"(vb), "i"(OFF) : "memory"); return r;
}
template <int NCB, int D0> __device__ __forceinline__ void pv_one(f32x16& od, int vb, bf16x8 pa0, bf16x8 pa1, bf16x8 pa2, bf16x8 pa3) {
#define VOFF(ks, half) (((2 * (ks) + (half)) * NCB + D0) * 512)
  const s16x4 l0 = tr_read<VOFF(0, 0)>(vb), h0 = tr_read<VOFF(0, 1)>(vb), l1 = tr_read<VOFF(1, 0)>(vb), h1 = tr_read<VOFF(1, 1)>(vb);
  const s16x4 l2 = tr_read<VOFF(2, 0)>(vb), h2 = tr_read<VOFF(2, 1)>(vb), l3 = tr_read<VOFF(3, 0)>(vb), h3 = tr_read<VOFF(3, 1)>(vb);
#undef VOFF
  asm volatile("s_waitcnt lgkmcnt(0)" ::: "memory"); SBAR();
#define PK(L, H) (bf16x8){L[0], L[1], L[2], L[3], H[0], H[1], H[2], H[3]}
  od = __builtin_amdgcn_mfma_f32_32x32x16_bf16(pa0, PK(l0, h0), od, 0, 0, 0);
  od = __builtin_amdgcn_mfma_f32_32x32x16_bf16(pa1, PK(l1, h1), od, 0, 0, 0);
  od = __builtin_amdgcn_mfma_f32_32x32x16_bf16(pa2, PK(l2, h2), od, 0, 0, 0);
  od = __builtin_amdgcn_mfma_f32_32x32x16_bf16(pa3, PK(l3, h3), od, 0, 0, 0);
#undef PK
}
template <int NCB, int KS> __device__ __forceinline__ void v_reads_ks(s16x4 (&v)[8], int vb) {
#define VOFF(d, half) (((2 * KS + (half)) * NCB + (d)) * 512)
  v[0] = tr_read<VOFF(0, 0)>(vb); v[1] = tr_read<VOFF(0, 1)>(vb); v[2] = tr_read<VOFF(1, 0)>(vb); v[3] = tr_read<VOFF(1, 1)>(vb);
  v[4] = tr_read<VOFF(2, 0)>(vb); v[5] = tr_read<VOFF(2, 1)>(vb); v[6] = tr_read<VOFF(3, 0)>(vb); v[7] = tr_read<VOFF(3, 1)>(vb);
#undef VOFF
}
__device__ __forceinline__ void pv_mm_ks(f32x16 (&o)[4], const s16x4 (&v)[8], bf16x8 pa) {
#define PK(L, H) (bf16x8){L[0], L[1], L[2], L[3], H[0], H[1], H[2], H[3]}
  o[0] = __builtin_amdgcn_mfma_f32_32x32x16_bf16(pa, PK(v[0], v[1]), o[0], 0, 0, 0);
  o[1] = __builtin_amdgcn_mfma_f32_32x32x16_bf16(pa, PK(v[2], v[3]), o[1], 0, 0, 0);
  o[2] = __builtin_amdgcn_mfma_f32_32x32x16_bf16(pa, PK(v[4], v[5]), o[2], 0, 0, 0);
  o[3] = __builtin_amdgcn_mfma_f32_32x32x16_bf16(pa, PK(v[6], v[7]), o[3], 0, 0, 0);
#undef PK
}
template <int NCB> __device__ __forceinline__ void pv_all(f32x16 (&o)[NCB], int vb, bf16x8 pa0, bf16x8 pa1, bf16x8 pa2, bf16x8 pa3) {
  if constexpr (NCB == 4) {
    s16x4 va[8], vc[8];
    v_reads_ks<4, 0>(va, vb);
    v_reads_ks<4, 1>(vc, vb); asm volatile("s_waitcnt lgkmcnt(8)" ::: "memory"); SBAR(); pv_mm_ks(o, va, pa0);
    v_reads_ks<4, 2>(va, vb); asm volatile("s_waitcnt lgkmcnt(8)" ::: "memory"); SBAR(); pv_mm_ks(o, vc, pa1);
    v_reads_ks<4, 3>(vc, vb); asm volatile("s_waitcnt lgkmcnt(8)" ::: "memory"); SBAR(); pv_mm_ks(o, va, pa2);
    asm volatile("s_waitcnt lgkmcnt(0)" ::: "memory"); SBAR(); pv_mm_ks(o, vc, pa3);
  } else {
    pv_one<NCB, 0>(o[0], vb, pa0, pa1, pa2, pa3); pv_one<NCB, 1>(o[1], vb, pa0, pa1, pa2, pa3);
  }
}

constexpr float THR = 8.f;
template <int DQK> struct ScaleOf { static constexpr float v = DQK == 64 ? 0.125f : DQK == 96 ? 0.10206207261596575f : 0.08838834764831845f; };

template <int DQK>
__device__ __forceinline__ void partialSM(f32x16& p0, f32x16& p1, float& m_reg, float& mn, float& alpha) {
  constexpr float SCALE = ScaleOf<DQK>::v, C = SCALE * LOG2E;
  float pmax = p0[0];
#pragma unroll
  for (int r = 1; r < 16; ++r) pmax = fmaxf(pmax, p0[r]);
#pragma unroll
  for (int r = 0; r < 16; ++r) pmax = fmaxf(pmax, p1[r]);
  { auto rr = __builtin_amdgcn_permlane32_swap(__float_as_uint(pmax), __float_as_uint(pmax), false, false);
    pmax = fmaxf(__uint_as_float(rr[0]), __uint_as_float(rr[1])); }
  if (__builtin_expect(__all(pmax - m_reg <= THR / SCALE), 1)) { mn = m_reg; alpha = 1.f; }
  else { mn = fmaxf(m_reg, pmax); alpha = __builtin_amdgcn_exp2f((m_reg - mn) * C); m_reg = mn; }
  const float mnC = -mn * C;
#pragma unroll
  for (int r = 0; r < 16; ++r) p0[r] = fmaf(p0[r], C, mnC);
#pragma unroll
  for (int r = 0; r < 16; ++r) p1[r] = fmaf(p1[r], C, mnC);
#pragma unroll
  for (int r = 0; r < 16; ++r) p0[r] = __builtin_amdgcn_exp2f(p0[r]);
}
__device__ __forceinline__ void finishSM(f32x16& p0, f32x16& p1, float alpha, float& l_reg, bf16x8& pa0, bf16x8& pa1, bf16x8& pa2, bf16x8& pa3) {
#pragma unroll
  for (int r = 0; r < 16; ++r) p1[r] = __builtin_amdgcn_exp2f(p1[r]);
  float ps = 0;
#pragma unroll
  for (int r = 0; r < 16; ++r) ps += p0[r];
#pragma unroll
  for (int r = 0; r < 16; ++r) ps += p1[r];
  { auto rr = __builtin_amdgcn_permlane32_swap(__float_as_uint(ps), __float_as_uint(ps), false, false);
    ps = __uint_as_float(rr[0]) + __uint_as_float(rr[1]); }
  l_reg = l_reg * alpha + ps;
#define PK4(Pv, BASE, OUT) do { unsigned a0 = cvtpk(Pv[BASE + 0], Pv[BASE + 1]), a1 = cvtpk(Pv[BASE + 2], Pv[BASE + 3]);   \
    unsigned b0 = cvtpk(Pv[BASE + 4], Pv[BASE + 5]), b1 = cvtpk(Pv[BASE + 6], Pv[BASE + 7]);                              \
    auto r0 = __builtin_amdgcn_permlane32_swap(a0, b0, false, false); auto r1 = __builtin_amdgcn_permlane32_swap(a1, b1, false, false); \
    u32x4 w = {r0[0], r1[0], r0[1], r1[1]}; OUT = *reinterpret_cast<bf16x8*>(&w); } while (0)
  PK4(p0, 0, pa0); PK4(p0, 8, pa1); PK4(p1, 0, pa2); PK4(p1, 8, pa3);
#undef PK4
}
template <int DQK>
__device__ __forceinline__ void qkt(f32x16& p0, f32x16& p1, const char* Ks, const bf16x8 (&qr)[DQK / 16], int r32, int hi) {
  constexpr int KSTR = DQK * 2 + 16;
  p0 = f32x16{}; p1 = f32x16{};
#pragma unroll
  for (int d0 = 0; d0 < DQK / 16; ++d0) { const int cb = (d0 * 16 + hi * 8) * 2;
    const bf16x8 b0 = *reinterpret_cast<const bf16x8*>(Ks + r32 * KSTR + cb);
    const bf16x8 b1 = *reinterpret_cast<const bf16x8*>(Ks + (32 + r32) * KSTR + cb);
    p0 = __builtin_amdgcn_mfma_f32_32x32x16_bf16(b0, qr[d0], p0, 0, 0, 0);
    p1 = __builtin_amdgcn_mfma_f32_32x32x16_bf16(b1, qr[d0], p1, 0, 0, 0); }
}
__device__ __forceinline__ void swa_mask(f32x16& p0, f32x16& p1, int kp0, int qpos, int hi) {
  const float ninf = -__builtin_inff();
#pragma unroll
  for (int r = 0; r < 16; ++r) {
    const int d0 = kp0 + crow(r, hi) - qpos, d1 = d0 + 32;
    if (d0 > 128 || d0 < -128) p0[r] = ninf;
    if (d1 > 128 || d1 < -128) p1[r] = ninf;
  }
}

template <int OFF> __device__ __forceinline__ bf16x8 lds_rd128(int a) {
  bf16x8 r; asm volatile("ds_read_b128 %0, %1 offset:%2" : "=&v"(r) : "v"(a), "i"(OFF) : "memory"); return r;
}
#define WAITL(n) do { asm volatile("s_waitcnt lgkmcnt(" #n ")" ::: "memory"); SBAR(); } while (0)
template <int NCB, int D0> __device__ __forceinline__ void v_reads(s16x4 (&v)[8], int vb) {
#define VOFF(ks, half) (((2 * (ks) + (half)) * NCB + D0) * 512)
  v[0] = tr_read<VOFF(0, 0)>(vb); v[1] = tr_read<VOFF(0, 1)>(vb); v[2] = tr_read<VOFF(1, 0)>(vb); v[3] = tr_read<VOFF(1, 1)>(vb);
  v[4] = tr_read<VOFF(2, 0)>(vb); v[5] = tr_read<VOFF(2, 1)>(vb); v[6] = tr_read<VOFF(3, 0)>(vb); v[7] = tr_read<VOFF(3, 1)>(vb);
#undef VOFF
}
__device__ __forceinline__ void pv_mm(f32x16& od, const s16x4 (&v)[8], bf16x8 pa0, bf16x8 pa1, bf16x8 pa2, bf16x8 pa3) {
#define PK(L, H) (bf16x8){L[0], L[1], L[2], L[3], H[0], H[1], H[2], H[3]}
  od = __builtin_amdgcn_mfma_f32_32x32x16_bf16(pa0, PK(v[0], v[1]), od, 0, 0, 0);
  od = __builtin_amdgcn_mfma_f32_32x32x16_bf16(pa1, PK(v[2], v[3]), od, 0, 0, 0);
  od = __builtin_amdgcn_mfma_f32_32x32x16_bf16(pa2, PK(v[4], v[5]), od, 0, 0, 0);
  od = __builtin_amdgcn_mfma_f32_32x32x16_bf16(pa3, PK(v[6], v[7]), od, 0, 0, 0);
#undef PK
}
template <int DQK, int DV, bool DOQK>
__device__ __forceinline__ void mseg_body(f32x16& p0, f32x16& p1, f32x16 (&o)[DV / 32], const bf16x8 (&qr)[DQK / 16], int ka, int vb,
                                          bf16x8 pa0, bf16x8 pa1, bf16x8 pa2, bf16x8 pa3) {
  constexpr int NCB = DV / 32, KSTR = DQK * 2 + 16, R2 = 32 * KSTR;
  s16x4 va[8], vc[8];
#define QK2(KA, KB, D) do { p0 = __builtin_amdgcn_mfma_f32_32x32x16_bf16(KA, qr[D], p0, 0, 0, 0); p1 = __builtin_amdgcn_mfma_f32_32x32x16_bf16(KB, qr[D], p1, 0, 0, 0); } while (0)
  if constexpr (!DOQK) {
    v_reads<NCB, 0>(va, vb); v_reads<NCB, 1>(vc, vb);
  } else if constexpr (DQK == 64) {
    const bf16x8 k0 = lds_rd128<0>(ka), k1 = lds_rd128<R2>(ka), k2 = lds_rd128<32>(ka), k3 = lds_rd128<R2 + 32>(ka);
    const bf16x8 k4 = lds_rd128<64>(ka), k5 = lds_rd128<R2 + 64>(ka), k6 = lds_rd128<96>(ka), k7 = lds_rd128<R2 + 96>(ka);
    v_reads<NCB, 0>(va, vb); WAITL(8);
    v_reads<NCB, 1>(vc, vb);
    p0 = f32x16{}; p1 = f32x16{};
    QK2(k0, k1, 0); QK2(k2, k3, 1); QK2(k4, k5, 2); QK2(k6, k7, 3);
  } else if constexpr (DQK == 96) {
    const bf16x8 k0 = lds_rd128<0>(ka), k1 = lds_rd128<R2>(ka), k2 = lds_rd128<32>(ka), k3 = lds_rd128<R2 + 32>(ka), k4 = lds_rd128<64>(ka), k5 = lds_rd128<R2 + 64>(ka);
    const bf16x8 k6 = lds_rd128<96>(ka), k7 = lds_rd128<R2 + 96>(ka), k8 = lds_rd128<128>(ka), k9 = lds_rd128<R2 + 128>(ka), k10 = lds_rd128<160>(ka), k11 = lds_rd128<R2 + 160>(ka);
    WAITL(6);
    v_reads<NCB, 0>(va, vb);
    p0 = f32x16{}; p1 = f32x16{};
    QK2(k0, k1, 0); QK2(k2, k3, 1); QK2(k4, k5, 2);
    WAITL(8);
    v_reads<NCB, 1>(vc, vb);
    QK2(k6, k7, 3); QK2(k8, k9, 4); QK2(k10, k11, 5);
  } else {
    const bf16x8 k0 = lds_rd128<0>(ka), k1 = lds_rd128<R2>(ka), k2 = lds_rd128<32>(ka), k3 = lds_rd128<R2 + 32>(ka);
    const bf16x8 k4 = lds_rd128<64>(ka), k5 = lds_rd128<R2 + 64>(ka), k6 = lds_rd128<96>(ka), k7 = lds_rd128<R2 + 96>(ka);
    v_reads<NCB, 0>(va, vb); WAITL(8);
    p0 = f32x16{}; p1 = f32x16{};
    QK2(k0, k1, 0); QK2(k2, k3, 1); QK2(k4, k5, 2); QK2(k6, k7, 3);
    const bf16x8 j0 = lds_rd128<128>(ka), j1 = lds_rd128<R2 + 128>(ka), j2 = lds_rd128<160>(ka), j3 = lds_rd128<R2 + 160>(ka);
    const bf16x8 j4 = lds_rd128<192>(ka), j5 = lds_rd128<R2 + 192>(ka), j6 = lds_rd128<224>(ka), j7 = lds_rd128<R2 + 224>(ka);
    v_reads<NCB, 1>(vc, vb); WAITL(8);
    QK2(j0, j1, 4); QK2(j2, j3, 5); QK2(j4, j5, 6); QK2(j6, j7, 7);
  }
#undef QK2
  if constexpr (NCB == 4) {
    WAITL(8); pv_mm(o[0], va, pa0, pa1, pa2, pa3);
    v_reads<NCB, 2>(va, vb); WAITL(8); pv_mm(o[1], vc, pa0, pa1, pa2, pa3);
    v_reads<NCB, 3>(vc, vb); WAITL(8); pv_mm(o[2], va, pa0, pa1, pa2, pa3);
    WAITL(0); pv_mm(o[3], vc, pa0, pa1, pa2, pa3);
  } else {
    WAITL(8); pv_mm(o[0], va, pa0, pa1, pa2, pa3);
    WAITL(0); pv_mm(o[1], vc, pa0, pa1, pa2, pa3);
  }
}

template <int DQK, bool FAST>
__device__ __forceinline__ void softmax_tile(f32x16& p0, f32x16& p1, float& m_reg, float& l_reg, float& alpha, bf16x8& pa0, bf16x8& pa1, bf16x8& pa2, bf16x8& pa3) {
  constexpr float SCALE = ScaleOf<DQK>::v, C = SCALE * LOG2E;
  if constexpr (FAST) {
#pragma unroll
    for (int r = 0; r < 16; ++r) p0[r] = __builtin_amdgcn_exp2f(p0[r]);
#pragma unroll
    for (int r = 0; r < 16; ++r) p1[r] = __builtin_amdgcn_exp2f(p1[r]);
  } else {
  float pmax = p0[0];
#pragma unroll
  for (int r = 1; r < 16; ++r) pmax = fmaxf(pmax, p0[r]);
#pragma unroll
  for (int r = 0; r < 16; ++r) pmax = fmaxf(pmax, p1[r]);
  { auto rr = __builtin_amdgcn_permlane32_swap(__float_as_uint(pmax), __float_as_uint(pmax), false, false);
    pmax = fmaxf(__uint_as_float(rr[0]), __uint_as_float(rr[1])); }
  const bool any = __any((pmax - m_reg) > THR / SCALE);
  const float mn = any ? fmaxf(m_reg, pmax) : m_reg;
  alpha = __builtin_amdgcn_exp2f((m_reg - mn) * C);
  m_reg = mn;
  const float mnC = -mn * C;
#pragma unroll
  for (int r = 0; r < 16; ++r) p0[r] = __builtin_amdgcn_exp2f(fmaf(p0[r], C, mnC));
#pragma unroll
  for (int r = 0; r < 16; ++r) p1[r] = __builtin_amdgcn_exp2f(fmaf(p1[r], C, mnC));
  }
  float ps = 0;
#pragma unroll
  for (int r = 0; r < 16; ++r) ps += p0[r];
#pragma unroll
  for (int r = 0; r < 16; ++r) ps += p1[r];
  { auto rr = __builtin_amdgcn_permlane32_swap(__float_as_uint(ps), __float_as_uint(ps), false, false);
    ps = __uint_as_float(rr[0]) + __uint_as_float(rr[1]); }
  if constexpr (FAST) l_reg += ps; else l_reg = l_reg * alpha + ps;
#define PK4(Pv, BASE, OUT) do { u32x4 w = {cvtpk(Pv[BASE + 0], Pv[BASE + 1]), cvtpk(Pv[BASE + 2], Pv[BASE + 3]), cvtpk(Pv[BASE + 4], Pv[BASE + 5]), cvtpk(Pv[BASE + 6], Pv[BASE + 7])}; \
    OUT = *reinterpret_cast<bf16x8*>(&w); } while (0)
  PK4(p0, 0, pa0); PK4(p0, 8, pa1); PK4(p1, 0, pa2); PK4(p1, 8, pa3);
#undef PK4
}

template <int DQK, int DV, bool SWA, bool FAST>
__device__ __forceinline__ bool attn_core(f32x16 (&o)[DV / 32], const bf16x8 (&qr)[DQK / 16],
    const bf16_t* __restrict__ Kp, int ldk, const bf16_t* __restrict__ Kp2, int ldk2, const bf16_t* __restrict__ Vp, int ldv,
    int NT, int NL, int lo, int qpos, float sink_l2, char* lds) {
  constexpr int NCB = DV / 32, KSTR = DQK * 2 + 16, SHM_K = 64 * KSTR, SHM_V = 64 * DV * 2;
  constexpr int NKC = DQK == 64 ? 1 : 2, NVC = DV / 64;
  constexpr float SCALE = ScaleOf<DQK>::v, C = SCALE * LOG2E;
  int tid = threadIdx.x; LAUNDER_V(tid);
  const int wid = tid >> 6, lane = tid & 63, r32 = lane & 31, hi = lane >> 5;
  const bool grp1 = (wid & 4) != 0;
  char* V_lds = lds; char* K_lds = lds + 4 * SHM_V;
  float* wsf = (float*)(lds + 4 * SHM_V + 4 * SHM_K) + wid * 64; float* li_l = wsf; float* al_l = wsf + 32;
  float m_reg = -1e30f, l_reg = 0.f, alpha = 1.f;
#pragma unroll
  for (int d = 0; d < NCB; ++d) o[d] = f32x16{};
  unsigned ko[NKC]; int kl[NKC]; unsigned vo[NVC]; int vl[NVC];
  if constexpr (DQK == 128) {
#pragma unroll
    for (int i = 0; i < 2; ++i) { const int row = (tid >> 4) + 32 * i, c = tid & 15; ko[i] = (unsigned)(row * ldk + c * 8) * 2u; kl[i] = row * KSTR + c * 16; }
  } else if constexpr (DQK == 64) {
    const int row = tid >> 3, c = tid & 7; ko[0] = (unsigned)(row * ldk + c * 8) * 2u; kl[0] = row * KSTR + c * 16;
  } else {
    { const int row = tid >> 3, c = tid & 7; ko[0] = (unsigned)(row * ldk + c * 8) * 2u; kl[0] = row * KSTR + c * 16; }
    { const int t2 = tid & 255; const int row = t2 >> 2, c = t2 & 3; ko[1] = (unsigned)(row * ldk2 + c * 8) * 2u; kl[1] = row * KSTR + (8 + c) * 16; }
  }
  if constexpr (DV == 128) {
#pragma unroll
    for (int i = 0; i < 2; ++i) { const int row = (tid >> 4) + 32 * i, c = (tid & 15) * 8; vo[i] = (unsigned)(row * ldv + c) * 2u; vl[i] = v_st<NCB>(row, c); }
  } else {
    const int row = tid >> 3, c = (tid & 7) * 8; vo[0] = (unsigned)(row * ldv + c) * 2u; vl[0] = v_st<NCB>(row, c);
  }
  const int vb0 = (int)(uintptr_t)V_lds + v_rd_base(lane);
  const int ka0 = (int)(uintptr_t)K_lds + r32 * KSTR + hi * 16;
  bf16x8 sk[2][NKC], sv[2][NVC];
#define TROW(j) ((j) < NL ? lo + 64 * (j) : SEQ + 64 * ((j) - NL))
#define SLOAD(s, j) do { const size_t ro_ = (size_t)TROW(j); const char* kb_ = (const char*)Kp + ro_ * ldk * 2; const char* vb_ = (const char*)Vp + ro_ * ldv * 2; \
    sk[s][0] = *(const bf16x8*)(kb_ + ko[0]); \
    if constexpr (DQK == 128) sk[s][NKC - 1] = *(const bf16x8*)(kb_ + ko[NKC - 1]); \
    if constexpr (DQK == 96) sk[s][NKC - 1] = *(const bf16x8*)((const char*)Kp2 + ro_ * ldk2 * 2 + ko[NKC - 1]); \
    _Pragma("unroll") for (int i_ = 0; i_ < NVC; ++i_) sv[s][i_] = *(const bf16x8*)(vb_ + vo[i_]); } while (0)
#define SWRITE(slot, s) do { _Pragma("unroll") for (int i_ = 0; i_ < NVC; ++i_) *(bf16x8*)(V_lds + (slot) * SHM_V + vl[i_]) = sv[s][i_]; \
    _Pragma("unroll") for (int i_ = 0; i_ < NKC; ++i_) *(bf16x8*)(K_lds + (slot) * SHM_K + kl[i_]) = sk[s][i_]; } while (0)
#define RESC(a) do { if (__any((a) < 1.f)) { if (hi == 0) al_l[r32] = (a); asm volatile("s_waitcnt lgkmcnt(0)" ::: "memory"); \
    _Pragma("unroll") for (int d = 0; d < NCB; ++d) _Pragma("unroll") for (int r = 0; r < 16; ++r) o[d][r] *= al_l[crow(r, hi)]; } } while (0)
#define MASK(pa_, pb_, j) do { if constexpr (SWA) { if ((j) < NL) swa_mask(pa_, pb_, lo + 64 * (j), qpos, hi); } } while (0)
#define VSEG(t) do { SBAR(); softmax_tile<DQK, FAST>(pn0, pn1, m_reg, l_reg, alpha, pa0, pa1, pa2, pa3); if constexpr (!FAST) RESC(alpha); SBAR(); \
    if ((t) + 1 < NT) { qkt<DQK>(pn0, pn1, K_lds + (((t) + 1) & 3) * SHM_K, qr, r32, hi); MASK(pn0, pn1, (t) + 1); } \
    SBAR(); __syncthreads(); } while (0)
#define MSEG(t, STG) do { SBAR(); __builtin_amdgcn_s_setprio(2); \
    if ((t) + 3 < NT) { SWRITE(((t) + 3) & 3, STG); if ((t) + 5 < NT) SLOAD(STG, (t) + 5); } \
    const int vbt_ = vb0 + ((t) & 3) * SHM_V; \
    if constexpr (DV == 64) mseg_body<DQK, DV, false>(pn0, pn1, o, qr, ka0, vbt_, pa0, pa1, pa2, pa3); \
    else pv_all<NCB>(o, vbt_, pa0, pa1, pa2, pa3); \
    __builtin_amdgcn_s_setprio(0); SBAR(); __syncthreads(); } while (0)
  f32x16 pn0, pn1; bf16x8 pa0, pa1, pa2, pa3;
  SLOAD(0, 0); SLOAD(1, 1);
  SWRITE(0, 0); if (2 < NT) SLOAD(0, 2);
  SWRITE(1, 1); if (3 < NT) SLOAD(1, 3);
  __syncthreads();
  if (grp1) __syncthreads();
  if (2 < NT) { SWRITE(2, 0); if (4 < NT) SLOAD(0, 4); }
  qkt<DQK>(pn0, pn1, K_lds, qr, r32, hi); MASK(pn0, pn1, 0);
  __syncthreads();
  for (int t = 0; t < NT; t += 2) {
    VSEG(t); MSEG(t, 1);
    VSEG(t + 1); MSEG(t + 1, 0);
  }
  if (!grp1) __syncthreads();
  if constexpr (SWA) l_reg += FAST ? __builtin_amdgcn_exp2f(sink_l2) : __builtin_amdgcn_exp2f(sink_l2 - m_reg * C);
  const bool bad = __any(!(l_reg > 1.0e-20f && l_reg < 1.0e30f));
  if (hi == 0) li_l[r32] = l_reg; asm volatile("s_waitcnt lgkmcnt(0)" ::: "memory");
#pragma unroll
  for (int r = 0; r < 16; ++r) { const float rl = __builtin_amdgcn_rcpf(li_l[crow(r, hi)]);
#pragma unroll
    for (int d = 0; d < NCB; ++d) o[d][r] *= rl; }
  __syncthreads();
  return bad;
#undef TROW
#undef SLOAD
#undef SWRITE
#undef RESC
#undef MASK
#undef VSEG
#undef MSEG
}

__device__ __forceinline__ void scale8(bf16x8& v, float c) { float f[8]; unpack8(v, f);
#pragma unroll
  for (int e = 0; e < 8; ++e) f[e] *= c;
  v = pack8(f); }
__device__ __forceinline__ bool wg_any(bool flag, char* lds) {
  volatile int* w = (volatile int*)lds;
  if (threadIdx.x == 0) w[0] = 0;
  __syncthreads();
  if (flag && (threadIdx.x & 63) == 0) w[0] = 1;
  __syncthreads();
  const bool r = w[0] != 0;
  __syncthreads();
  return r;
}
#define ATTN_PASS(DQK_, DV_, SWA_, ...) do { constexpr float Cq_ = ScaleOf<DQK_>::v * LOG2E; \
    _Pragma("unroll") for (int d0 = 0; d0 < DQK_ / 16; ++d0) scale8(qr[d0], Cq_); \
    bool bad_ = attn_core<DQK_, DV_, SWA_, true>(__VA_ARGS__); \
    if (wg_any(bad_, lds)) { _Pragma("unroll") for (int d0 = 0; d0 < DQK_ / 16; ++d0) scale8(qr[d0], 1.f / Cq_); \
      attn_core<DQK_, DV_, SWA_, false>(__VA_ARGS__); } } while (0)

template <int KIND>
__device__ __forceinline__ void attn_item(const P& p, int b, int h, int qb, bool is_ctx, char* lds) {
  constexpr int DQK = KIND == 0 ? 96 : KIND == 2 ? 128 : 64;
  constexpr int DV = (KIND == 1 || KIND == 2) ? 128 : 64;
  constexpr int NCB = DV / 32;
  int tid = threadIdx.x; LAUNDER_V(tid);
  const int wid = tid >> 6, lane = tid & 63, r32 = lane & 31, hi = lane >> 5;
  const int rowb = b * TPB;
  const int q_t0 = is_ctx ? SEQ : qb * 256;
  const int qt = q_t0 + wid * 32 + r32;
  const size_t qrow = (size_t)rowb + qt;
  const int krow0 = is_ctx ? rowb + SEQ : rowb;
  int NT, NL, lo;
  if (is_ctx) { NT = 4; NL = 4; lo = 0; }
  else if (KIND == 3) { lo = q_t0 - 128 < 0 ? 0 : q_t0 - 128; const int he = q_t0 + 384 > SEQ ? SEQ : q_t0 + 384; NL = (he - lo) / 64; NT = NL + 4; }
  else { NT = TPB / 64; NL = NT; lo = 0; }
  const float* rt = (const float*)(p.ws + WS_ROPE);
  const bf16_t* proj = (const bf16_t*)(p.ws + WS_PROJ);
  bf16_t* ob = (bf16_t*)(p.ws + WS_ABUF);
  const int prow = qt >> 6, pcol = qt & 63;
  f32x16 o[NCB];

  if constexpr (KIND == 1) {
    const float lam = ((const float*)(p.ws + WS_MISC))[0];
#pragma unroll 1
    for (int map = 0; map < 2; ++map) {
      const int m = 2 * h + map;
      bf16x8 qr[4];
      { const bf16_t* qp = proj + qrow * NPAD1 + m * 64 + hi * 8;
#pragma unroll
        for (int d0 = 0; d0 < 4; ++d0) qr[d0] = *(const bf16x8*)(qp + d0 * 16); }
      if (!is_ctx) {
        const float* T = rt + ROPE64_OFF;
        rope8(qr[0], qr[2], T + prow * 16 + hi * 8, T + 256 * 16 + prow * 16 + hi * 8);
        rope8(qr[1], qr[3], T + pcol * 16 + hi * 8, T + 256 * 16 + pcol * 16 + hi * 8);
      }
      ATTN_PASS(64, 128, false, o, qr, proj + (size_t)krow0 * NPAD1 + 1024 + m * 64, NPAD1, nullptr, 0,
                proj + (size_t)krow0 * NPAD1 + 2048 + h * 128, NPAD1, NT, NL, lo, qt, 0.f, lds);
      char* obw = (char*)(ob + ((size_t)rowb + q_t0) * 1024 + h * 128);
      const char* gbw = (const char*)(proj + ((size_t)rowb + q_t0) * NPAD1 + 3072 + h * 128);
      int te = threadIdx.x; LAUNDER_V(te);
      const int wid = te >> 6, r32 = te & 31, hi = (te >> 5) & 1;
      const unsigned oo = (unsigned)((wid * 32 + 4 * hi) * 1024 + r32) * 2u;
      const unsigned go = (unsigned)((wid * 32 + 4 * hi) * NPAD1 + r32) * 2u;
      if (map == 0) {
#pragma unroll
        for (int r = 0; r < 16; ++r) {
          const unsigned ro = oo + (unsigned)(((r & 3) + 8 * (r >> 2)) * 2048);
#pragma unroll
          for (int d = 0; d < 4; ++d) *(bf16_t*)(obw + ro + d * 64) = f2bf(o[d][r]);
          if ((r & 3) == 3) SBAR();
        }
      } else {
        float gs[4];
#pragma unroll
        for (int d = 0; d < 4; ++d) gs[d] = p.diff_g_sub[d * 32 + r32] * (1.f - LAMBDA_INIT);
#pragma unroll
        for (int r = 0; r < 16; ++r) {
          const unsigned ro = oo + (unsigned)(((r & 3) + 8 * (r >> 2)) * 2048);
          const unsigned rg = go + (unsigned)(((r & 3) + 8 * (r >> 2)) * (NPAD1 * 2));
          float dv[4]; float ss = 0.f;
#pragma unroll
          for (int d = 0; d < 4; ++d) { const float o1 = bf2f((short)*(const bf16_t*)(obw + ro + d * 64)); dv[d] = o1 - lam * o[d][r]; ss += dv[d] * dv[d]; }
          ss += __shfl_xor(ss, 1); ss += __shfl_xor(ss, 2); ss += __shfl_xor(ss, 4); ss += __shfl_xor(ss, 8); ss += __shfl_xor(ss, 16);
          const float rstd = rsqrtf(ss * (1.f / 128.f) + EPS);
#pragma unroll
          for (int d = 0; d < 4; ++d) {
            const float g = bf2f((short)*(const bf16_t*)(gbw + rg + d * 64));
            *(bf16_t*)(obw + ro + d * 64) = f2bf(dv[d] * rstd * gs[d] * silu_f(g));
          }
          if ((r & 1) == 1) SBAR();
        }
      }
    }
  } else {
    bf16x8 qr[DQK / 16];
    const bf16_t *Kp, *Kp2 = nullptr, *Vp, *gbase; int ldk, ldk2 = 0, ldv, ldg; float sink_l2 = 0.f;
    if constexpr (KIND == 0) {
      const bf16_t* q2 = (const bf16_t*)(p.ws + WS_X); const bf16_t* kv2 = (const bf16_t*)(p.ws + WS_KV2);
      const bf16_t* qp = q2 + qrow * 1536 + h * 96 + hi * 8;
#pragma unroll
      for (int d0 = 0; d0 < 6; ++d0) qr[d0] = *(const bf16x8*)(qp + d0 * 16);
      if (!is_ctx) { const int pos = hi ? pcol : prow; const float* T = rt + ROPE32_OFF; rope8(qr[4], qr[5], T + pos * 8, T + 256 * 8 + pos * 8); }
      Kp = kv2 + (size_t)krow0 * 2048 + h * 128; ldk = 2048; Kp2 = proj + (size_t)krow0 * NPAD0 + 384; ldk2 = NPAD0;
      Vp = kv2 + (size_t)krow0 * 2048 + h * 128 + 64; ldv = 2048;
      gbase = proj + ((size_t)rowb + q_t0) * NPAD0 + 416 + h * 64; ldg = NPAD0;
    } else if constexpr (KIND == 2) {
      const bf16_t* qp = proj + qrow * NPAD2 + h * 128 + hi * 8;
      float ss = 0.f; float xf[8][8];
#pragma unroll
      for (int d0 = 0; d0 < 8; ++d0) { unpack8(*(const bf16x8*)(qp + d0 * 16), xf[d0]);
#pragma unroll
        for (int e = 0; e < 8; ++e) ss += xf[d0][e] * xf[d0][e]; }
      ss += __shfl_xor(ss, 32);
      const float rstd = rsqrtf(ss * (1.f / 128.f) + EPS);
#pragma unroll
      for (int d0 = 0; d0 < 8; ++d0) {
        const f32x4 g0 = *(const f32x4*)(p.gqa_g_q + d0 * 16 + hi * 8), g1 = *(const f32x4*)(p.gqa_g_q + d0 * 16 + hi * 8 + 4);
#pragma unroll
        for (int e = 0; e < 8; ++e) xf[d0][e] *= rstd * (e < 4 ? g0[e & 3] : g1[e & 3]);
      }
      if (!is_ctx) {
        const float* T = rt + ROPE128_OFF;
#pragma unroll
        for (int d0 = 0; d0 < 4; ++d0) { const int pos = d0 < 2 ? prow : pcol; const int f0 = (d0 & 1) * 16 + hi * 8;
          rope8f(xf[d0], xf[d0 + 4], T + pos * 32 + f0, T + 256 * 32 + pos * 32 + f0); }
      }
#pragma unroll
      for (int d0 = 0; d0 < 8; ++d0) qr[d0] = pack8(xf[d0]);
      const int kvh = h >> 2;
      Kp = proj + (size_t)krow0 * NPAD2 + 1024 + kvh * 128; ldk = NPAD2; Vp = proj + (size_t)krow0 * NPAD2 + 1280 + kvh * 128; ldv = NPAD2;
      gbase = proj + ((size_t)rowb + q_t0) * NPAD2 + 1536 + h * 128; ldg = NPAD2;
    } else {
      const bf16_t* qp = proj + qrow * NPAD3 + h * 64 + hi * 8;
#pragma unroll
      for (int d0 = 0; d0 < 4; ++d0) qr[d0] = *(const bf16x8*)(qp + d0 * 16);
      if (!is_ctx) {
        const float* T = rt + ROPE64_OFF;
        rope8(qr[0], qr[2], T + prow * 16 + hi * 8, T + 256 * 16 + prow * 16 + hi * 8);
        rope8(qr[1], qr[3], T + pcol * 16 + hi * 8, T + 256 * 16 + pcol * 16 + hi * 8);
      }
      const int kvh = h >> 3;
      Kp = proj + (size_t)krow0 * NPAD3 + 1024 + kvh * 64; ldk = NPAD3; Vp = proj + (size_t)krow0 * NPAD3 + 1152 + kvh * 64; ldv = NPAD3;
      gbase = proj + ((size_t)rowb + q_t0) * NPAD3 + 1280 + h * 64; ldg = NPAD3;
      sink_l2 = p.swa_sink[h] * LOG2E;
    }
    ATTN_PASS(DQK, DV, KIND == 3, o, qr, Kp, ldk, Kp2, ldk2, Vp, ldv, NT, NL, lo, qt, sink_l2, lds);
    char* obw = (char*)(ob + ((size_t)rowb + q_t0) * 1024 + h * DV);
    const char* gbw = (const char*)gbase;
    int te = threadIdx.x; LAUNDER_V(te);
    const int wid2 = te >> 6, r32b = te & 31, hi2 = (te >> 5) & 1;
    const unsigned oo = (unsigned)((wid2 * 32 + 4 * hi2) * 1024 + r32b) * 2u;
    const unsigned go = (unsigned)((wid2 * 32 + 4 * hi2) * ldg + r32b) * 2u;
#pragma unroll
    for (int r = 0; r < 16; ++r) {
      const unsigned ro = oo + (unsigned)(((r & 3) + 8 * (r >> 2)) * 2048);
      const unsigned rg = go + (unsigned)(((r & 3) + 8 * (r >> 2)) * ldg * 2);
#pragma unroll
      for (int d = 0; d < NCB; ++d) {
        const float g = bf2f((short)*(const bf16_t*)(gbw + rg + d * 64));
        *(bf16_t*)(obw + ro + d * 64) = f2bf(o[d][r] * silu_f(g));
      }
      if ((r & 3) == 3) SBAR();
    }
  }
}

template <int KIND>
__device__ __forceinline__ void phase_attn(const P& p, char* lds) {
  constexpr int H = (KIND == 0 || KIND == 3) ? 16 : 8;
  constexpr int nlat = NBATCH * H * 64, nctx = KIND < 3 ? NBATCH * H : 0;
  for (int it = blockIdx.x; it < nlat + nctx; it += gridDim.x) {
    if (it < nlat) {
      int qb = it & 63, hh = it >> 6;
      if (gridDim.x == 256) {
        const int x = it & 7, j = (it & 255) >> 3; hh = (it >> 8) * 4 + (x >> 1); qb = j + 32 * (x & 1);
      }
      attn_item<KIND>(p, hh / H, hh % H, qb, false, lds);
    }
    else { const int j = it - nlat; attn_item<KIND>(p, j / H, j % H, 0, true, lds); }
  }
}

__device__ __forceinline__ P load_params() {
#if defined(__HIP_DEVICE_COMPILE__)
  auto pp = (const __attribute__((address_space(4))) P*)__builtin_amdgcn_kernarg_segment_ptr();
  asm volatile("" : "+s"(pp));
  return *pp;
#else
  return P{};
#endif
}
__global__ __launch_bounds__(NTHR) void mega(P p_unused) {
  extern __shared__ __attribute__((aligned(16))) char lds[];
  cg::grid_group grid = cg::this_grid();
  phase_prep(load_params(), lds); grid.sync();
#define GSYNC(k) grid_barrier((unsigned*)(load_params().ws + WS_BAR), (unsigned)(k))
  phase_h0(load_params()); GSYNC(1);
#pragma unroll 1
  for (int layer = 0; layer < 4; ++layer) {
    const int e0 = 2 + 5 * layer;
    phase_gemm1(load_params(), layer, lds); GSYNC(e0);
    if (layer == 0) { phase_kfix<0>(load_params()); phase_gemm2(load_params(), lds); }
    else if (layer == 1) phase_kfix<1>(load_params());
    else if (layer == 2) phase_kfix<2>(load_params());
    else phase_kfix<3>(load_params());
    GSYNC(e0 + 1);
    if (layer == 0) phase_attn<0>(load_params(), lds);
    else if (layer == 1) phase_attn<1>(load_params(), lds);
    else if (layer == 2) phase_attn<2>(load_params(), lds);
    else phase_attn<3>(load_params(), lds);
    GSYNC(e0 + 2);
    phase_outproj(load_params(), layer, lds); GSYNC(e0 + 3);
    phase_ln(load_params(), layer);
    if (layer < 3) GSYNC(e0 + 4);
  }
}

extern "C" void kernel_launch(void* const* d_in, const int* in_sizes, int n_in, void* d_out, int out_size, void* d_ws, size_t ws_size, hipStream_t stream) {
  static int grid_blocks = 0;
  if (!grid_blocks) {
    if (ws_size < WS_END) { fprintf(stderr, "kernel_launch: workspace too small: %zu < %zu\n", ws_size, (size_t)WS_END); return; }
    if (hipFuncSetAttribute((const void*)mega, hipFuncAttributeMaxDynamicSharedMemorySize, LDS_BYTES) != hipSuccess) { fprintf(stderr, "kernel_launch: LDS attribute failed\n"); return; }
    int dev = 0, cus = 0, per_cu = 0;
    hipGetDevice(&dev);
    hipDeviceGetAttribute(&cus, hipDeviceAttributeMultiprocessorCount, dev);
    hipOccupancyMaxActiveBlocksPerMultiprocessor(&per_cu, mega, NTHR, LDS_BYTES);
    if (per_cu < 1) { fprintf(stderr, "kernel_launch: occupancy 0\n"); return; }
    grid_blocks = cus * 1;
  }
  P p{};
  p.x = (const float*)d_in[0]; p.c = (const float*)d_in[1]; p.ctx = (const float*)d_in[2]; p.c_ctx = (const float*)d_in[3];
  p.ada_w = (const float*)d_in[4]; p.ada_b = (const float*)d_in[5]; p.out_w = (const float*)d_in[6]; p.ln_g = (const float*)d_in[7]; p.ln_b = (const float*)d_in[8];
  p.mla_w_in = (const float*)d_in[9]; p.mla_g_qa = (const float*)d_in[10]; p.mla_w_qb = (const float*)d_in[11]; p.mla_g_kva = (const float*)d_in[12]; p.mla_w_kvb = (const float*)d_in[13];
  p.diff_w_in = (const float*)d_in[14]; p.diff_lambda = (const float*)d_in[15]; p.diff_g_sub = (const float*)d_in[16];
  p.gqa_w_in = (const float*)d_in[17]; p.gqa_g_q = (const float*)d_in[18]; p.gqa_g_k = (const float*)d_in[19];
  p.swa_w_in = (const float*)d_in[20]; p.swa_sink = (const float*)d_in[21];
  p.out = (float*)d_out; p.ws = (char*)d_ws;
  hipMemsetAsync((char*)d_ws + WS_BAR, 0, 256, stream);
  void* args[] = {&p};
  hipError_t e = hipLaunchCooperativeKernel((const void*)mega, dim3(grid_blocks), dim3(NTHR), args, LDS_BYTES, stream);
  if (e != hipSuccess) fprintf(stderr, "cooperative launch failed: %s (grid %d)\n", hipGetErrorString(e), grid_blocks);
}
```

```cpp
#include <hip/hip_runtime.h>
#include <hip/hip_cooperative_groups.h>
#include <cstdio>
#include <cstdint>
namespace cg = cooperative_groups;

typedef unsigned short bf16_t;
using bf16x8 = __attribute__((ext_vector_type(8))) short;
using s16x4  = __attribute__((ext_vector_type(4))) short;
using f32x16 = __attribute__((ext_vector_type(16))) float;
using f32x4  = __attribute__((ext_vector_type(4))) float;
using u32x4  = __attribute__((ext_vector_type(4))) unsigned;
using u32x2  = __attribute__((ext_vector_type(2))) unsigned;

constexpr int DM = 1024, NBATCH = 2, SEQ = 16384, CTXL = 256, TPB = SEQ + CTXL, NROW = NBATCH * TPB;
constexpr int NTHR = 512;
constexpr float EPS = 1e-6f;
constexpr float ALPHA = 1.681792830507429f;
constexpr float LAMBDA_INIT = 0.35550906759096544f;
constexpr float LOG2E = 1.4426950408889634f;

constexpr size_t al256(size_t x) { return (x + 255) / 256 * 256; }
constexpr int NPAD0 = 1536, NPAD1 = 4096, NPAD2 = 2560, NPAD3 = 2304;
constexpr size_t WS_WIN0 = 0;
constexpr size_t WS_WIN1 = WS_WIN0 + (size_t)NPAD0 * 1024 * 2;
constexpr size_t WS_WIN2 = WS_WIN1 + (size_t)NPAD1 * 1024 * 2;
constexpr size_t WS_WIN3 = WS_WIN2 + (size_t)NPAD2 * 1024 * 2;
constexpr size_t WS_WOUT = WS_WIN3 + (size_t)NPAD3 * 1024 * 2;
constexpr size_t WS_WQB  = WS_WOUT + (size_t)4 * 1024 * 1024 * 2;
constexpr size_t WS_WKVB = WS_WQB + (size_t)1536 * 256 * 2;
constexpr size_t WS_MOD  = WS_WKVB + (size_t)2048 * 128 * 2;
constexpr size_t WS_ROPE = WS_MOD + (size_t)4 * 3 * 3072 * 4;
constexpr int ROPE32_OFF = 0, ROPE64_OFF = 256 * 8 * 2, ROPE128_OFF = ROPE64_OFF + 256 * 16 * 2, ROPE_TOTAL = ROPE128_OFF + 256 * 32 * 2;
constexpr size_t WS_MISC = WS_ROPE + (size_t)ROPE_TOTAL * 4;
constexpr size_t WS_BAR  = al256(WS_MISC + 256);
constexpr size_t WS_ABUF = al256(WS_BAR + 256);
constexpr size_t WS_X    = WS_ABUF + (size_t)NROW * 1024 * 2;
constexpr size_t WS_PROJ = WS_X + (size_t)NROW * 1024 * 4;
constexpr size_t WS_KV2  = WS_PROJ + (size_t)NROW * 1536 * 2;
constexpr size_t WS_END  = WS_PROJ + (size_t)NROW * 4096 * 2;

constexpr int LDS_BYTES = 143360;

struct P {
  const float *x, *c, *ctx, *c_ctx, *ada_w, *ada_b, *out_w, *ln_g, *ln_b;
  const float *mla_w_in, *mla_g_qa, *mla_w_qb, *mla_g_kva, *mla_w_kvb;
  const float *diff_w_in, *diff_lambda, *diff_g_sub;
  const float *gqa_w_in, *gqa_g_q, *gqa_g_k;
  const float *swa_w_in, *swa_sink;
  float* out; char* ws;
};

#define SBAR() __builtin_amdgcn_sched_barrier(0)
#define LAUNDER_V(x) asm volatile("" : "+v"(x))
__device__ __forceinline__ int crow(int r, int hi) { return (r & 3) + 8 * (r >> 2) + 4 * hi; }
__device__ __forceinline__ unsigned cvtpk(float lo, float hi) {
  unsigned r; asm volatile("v_cvt_pk_bf16_f32 %0, %1, %2" : "=v"(r) : "v"(lo), "v"(hi)); return r;
}
__device__ __forceinline__ float bf2f(short v) { return __uint_as_float(((unsigned)(unsigned short)v) << 16); }
__device__ __forceinline__ bf16_t f2bf(float f) { return (bf16_t)(cvtpk(f, f) & 0xffffu); }
__device__ __forceinline__ float silu_f(float v) { return v / (1.f + __expf(-v)); }

__device__ __forceinline__ void grid_barrier(unsigned* ctr, unsigned epoch) {
  asm volatile("s_waitcnt vmcnt(0) lgkmcnt(0)" ::: "memory");
  __syncthreads();
  if (threadIdx.x == 0) {
    __builtin_amdgcn_fence(__ATOMIC_RELEASE, "agent");
    asm volatile("s_waitcnt vmcnt(0)" ::: "memory");
    __hip_atomic_fetch_add(ctr, 1u, __ATOMIC_RELAXED, __HIP_MEMORY_SCOPE_AGENT);
    const unsigned target = epoch * gridDim.x;
    while (__hip_atomic_load(ctr, __ATOMIC_RELAXED, __HIP_MEMORY_SCOPE_AGENT) < target) __builtin_amdgcn_s_sleep(1);
    __builtin_amdgcn_fence(__ATOMIC_ACQUIRE, "agent");
    asm volatile("s_waitcnt vmcnt(0)" ::: "memory");
  }
  __syncthreads();
}

__device__ __forceinline__ void transpose_tile(const float* __restrict__ src, int K, int N, bf16_t* __restrict__ dst, const float* __restrict__ gain, int tk, int tn, float* tile) {
  int tid = threadIdx.x; LAUNDER_V(tid);
  {
    const int n = tid & 63, kb = tid >> 6;
#pragma unroll
    for (int i = 0; i < 8; ++i) {
      const int k = kb + 8 * i; const int gn = tn * 64 + n, gk = tk * 64 + k;
      float v = 0.f;
      if (gn < N) { v = src[(size_t)gk * N + gn]; if (gain) v *= gain[gk]; }
      tile[k * 65 + n] = v;
    }
  }
  __syncthreads();
  {
    const int kk = (tid & 31) * 2, nb = tid >> 5;
#pragma unroll
    for (int i = 0; i < 4; ++i) {
      const int nn = nb + 16 * i;
      const unsigned w = cvtpk(tile[kk * 65 + nn], tile[(kk + 1) * 65 + nn]);
      *(unsigned*)(dst + (size_t)(tn * 64 + nn) * K + tk * 64 + kk) = w;
    }
  }
  __syncthreads();
}

__device__ __forceinline__ void phase_prep(const P& p, char* lds) {
  int tid = threadIdx.x; LAUNDER_V(tid);
  float* tile = (float*)lds;
  constexpr int T0 = 16 * 24, T1 = 16 * 64, T2 = 16 * 40, T3 = 16 * 36, TO = 16 * 16, TQ = 4 * 24, TK = 2 * 32;
  constexpr int E0 = T0, E1 = E0 + T1, E2 = E1 + T2, E3 = E2 + T3, E4 = E3 + 4 * TO, E5 = E4 + TQ, E6 = E5 + TK;
  for (int t = blockIdx.x; t < E6; t += gridDim.x) {
    const float* src; int K, N, NP; bf16_t* dst; const float* gain = nullptr; int lt;
    if (t < E0)      { lt = t;      src = p.mla_w_in;  K = 1024; N = 1440; NP = NPAD0; dst = (bf16_t*)(p.ws + WS_WIN0); }
    else if (t < E1) { lt = t - E0; src = p.diff_w_in; K = 1024; N = 4096; NP = NPAD1; dst = (bf16_t*)(p.ws + WS_WIN1); }
    else if (t < E2) { lt = t - E1; src = p.gqa_w_in;  K = 1024; N = 2560; NP = NPAD2; dst = (bf16_t*)(p.ws + WS_WIN2); }
    else if (t < E3) { lt = t - E2; src = p.swa_w_in;  K = 1024; N = 2304; NP = NPAD3; dst = (bf16_t*)(p.ws + WS_WIN3); }
    else if (t < E4) { lt = t - E3; const int l = lt / TO; lt -= l * TO; src = p.out_w + (size_t)l * 1024 * 1024; K = 1024; N = 1024; NP = 1024; dst = (bf16_t*)(p.ws + WS_WOUT) + (size_t)l * 1024 * 1024; }
    else if (t < E5) { lt = t - E4; src = p.mla_w_qb;  K = 256; N = 1536; NP = 1536; dst = (bf16_t*)(p.ws + WS_WQB); gain = p.mla_g_qa; }
    else             { lt = t - E5; src = p.mla_w_kvb; K = 128; N = 2048; NP = 2048; dst = (bf16_t*)(p.ws + WS_WKVB); gain = p.mla_g_kva; }
    const int ntn = NP / 64; const int tk = lt / ntn, tn = lt % ntn;
    transpose_tile(src, K, N, dst, gain, tk, tn, tile);
  }
  {
    float* sv = (float*)lds;
    float* red = (float*)lds + 3072;
    for (int i = tid; i < 3072; i += NTHR) {
      const int v = i >> 10, k = i & 1023;
      const float cv = v == 0 ? p.c[k] : v == 1 ? p.c[1024 + k] : p.c_ctx[k];
      sv[i] = silu_f(cv);
    }
    __syncthreads();
    for (int it = blockIdx.x; it < 4 * 48; it += gridDim.x) {
      const int l = it / 48, n0 = (it % 48) * 64;
      const int n = tid & 63, kc = tid >> 6;
      const float* w = p.ada_w + (size_t)l * 1024 * 3072 + (size_t)(kc * 128) * 3072 + n0 + n;
      float a0 = 0.f, a1 = 0.f, a2 = 0.f;
#pragma unroll 8
      for (int k = 0; k < 128; ++k) {
        const float wv = w[(size_t)k * 3072];
        a0 += sv[kc * 128 + k] * wv; a1 += sv[1024 + kc * 128 + k] * wv; a2 += sv[2048 + kc * 128 + k] * wv;
      }
      red[(kc * 64 + n) * 3 + 0] = a0; red[(kc * 64 + n) * 3 + 1] = a1; red[(kc * 64 + n) * 3 + 2] = a2;
      __syncthreads();
      if (tid < 192) {
        const int v = tid >> 6, nn = tid & 63; float s = 0.f;
#pragma unroll
        for (int q = 0; q < 8; ++q) s += red[(q * 64 + nn) * 3 + v];
        s += p.ada_b[l * 3072 + n0 + nn];
        ((float*)(p.ws + WS_MOD))[(l * 3 + v) * 3072 + n0 + nn] = s;
      }
      __syncthreads();
    }
  }
  {
    float* rt = (float*)(p.ws + WS_ROPE);
    const int gt = blockIdx.x * NTHR + tid;
    for (int i = gt; i < 256 * 56; i += gridDim.x * NTHR) {
      const int pos = i / 56, j = i % 56;
      int nf, f, off;
      if (j < 8) { nf = 8; f = j; off = ROPE32_OFF; } else if (j < 24) { nf = 16; f = j - 8; off = ROPE64_OFF; } else { nf = 32; f = j - 24; off = ROPE128_OFF; }
      const float inv = exp2f(-(float)f / (float)nf * 13.287712379549449f);
      const float ang = (float)pos * inv;
      const float kq = rintf(ang * 0.15915494309189535f);
      float r = fmaf(-kq, 6.28318548202514648f, ang); r = fmaf(-kq, -1.7484555e-07f, r);
      rt[off + pos * nf + f] = cosf(r); rt[off + 256 * nf + pos * nf + f] = sinf(r);
    }
    if (blockIdx.x == 0 && tid < 64) {
      const float* lm = p.diff_lambda;
      float s1 = lm[tid] * lm[64 + tid], s2 = lm[128 + tid] * lm[192 + tid];
#pragma unroll
      for (int o = 32; o >= 1; o >>= 1) { s1 += __shfl_xor(s1, o); s2 += __shfl_xor(s2, o); }
      if (tid == 0) ((float*)(p.ws + WS_MISC))[0] = __expf(s1) - __expf(s2) + LAMBDA_INIT;
    }
  }
}

__device__ __forceinline__ void phase_h0(const P& p) {
  const float* mod = (const float*)(p.ws + WS_MOD);
  bf16_t* hb = (bf16_t*)(p.ws + WS_ABUF);
  const size_t total = (size_t)NROW * 128;
  int tid = threadIdx.x; LAUNDER_V(tid);
  for (size_t i = (size_t)blockIdx.x * NTHR + tid; i < total; i += (size_t)gridDim.x * NTHR) {
    const int row = (int)(i >> 7), c8 = (int)(i & 127) * 8;
    const int b = row / TPB, t = row % TPB;
    const float* src; int v;
    if (t < SEQ) { src = p.x + ((size_t)b * SEQ + t) * 1024; v = b; } else { src = p.ctx + ((size_t)b * CTXL + (t - SEQ)) * 1024; v = 2; }
    const float* sh = mod + v * 3072 + c8; const float* sc = sh + 1024;
    const f32x4 x0 = *(const f32x4*)(src + c8), x1 = *(const f32x4*)(src + c8 + 4);
    const f32x4 s0 = *(const f32x4*)sc, s1 = *(const f32x4*)(sc + 4), h0 = *(const f32x4*)sh, h1 = *(const f32x4*)(sh + 4);
    u32x4 w;
    w.x = cvtpk(x0[0] * (1.f + s0[0]) + h0[0], x0[1] * (1.f + s0[1]) + h0[1]);
    w.y = cvtpk(x0[2] * (1.f + s0[2]) + h0[2], x0[3] * (1.f + s0[3]) + h0[3]);
    w.z = cvtpk(x1[0] * (1.f + s1[0]) + h1[0], x1[1] * (1.f + s1[1]) + h1[1]);
    w.w = cvtpk(x1[2] * (1.f + s1[2]) + h1[2], x1[3] * (1.f + s1[3]) + h1[3]);
    *(u32x4*)(hb + (size_t)row * 1024 + c8) = w;
  }
}

template <int MB, class Epi>
__device__ __forceinline__ void gemm_tile(const bf16_t* __restrict__ A, int lda, const bf16_t* __restrict__ Bt, int ldb, int K, const Epi& epi, char* lds) {
  int tid = threadIdx.x; LAUNDER_V(tid);
  const int wid = tid >> 6, lane = tid & 63, r32 = lane & 31, hi = lane >> 5;
  const int m0 = (wid >> 2) * (MB * 32), n0 = (wid & 3) * 64;
  const int sc = tid & 7, sr = tid >> 3;
  const unsigned aofs = (unsigned)(sr * lda + sc * 8) * 2u, bofs = (unsigned)(sr * ldb + sc * 8) * 2u;
  const int sw = sr * 128 + ((sc ^ ((sr >> 1) & 7)) << 4);
  const int xr = (r32 >> 1) & 7;
  const int aoff = (m0 + r32) * 128, boff = 32768 + (n0 + r32) * 128;
  const int co0 = ((0 + hi) ^ xr) << 4, co1 = ((2 + hi) ^ xr) << 4, co2 = ((4 + hi) ^ xr) << 4, co3 = ((6 + hi) ^ xr) << 4;
  f32x16 acc[MB][2];
#pragma unroll
  for (int i = 0; i < MB; ++i) { acc[i][0] = f32x16{}; acc[i][1] = f32x16{}; }
  u32x4 ra[MB], rb[4];
  const int nk = K >> 6;
#define GLOAD(kt) do { const char* ab_ = (const char*)A + (size_t)(kt) * 128; const char* bb_ = (const char*)Bt + (size_t)(kt) * 128; \
    _Pragma("unroll") for (int i = 0; i < MB; ++i) ra[i] = *(const u32x4*)(ab_ + (size_t)(i * 64) * lda * 2 + aofs); \
    _Pragma("unroll") for (int i = 0; i < 4; ++i) rb[i] = *(const u32x4*)(bb_ + (size_t)(i * 64) * ldb * 2 + bofs); } while (0)
#define GWRITE(buf) do { _Pragma("unroll") for (int i = 0; i < MB; ++i) *(u32x4*)(lds + (buf) * 65536 + sw + i * 8192) = ra[i]; \
    _Pragma("unroll") for (int i = 0; i < 4; ++i) *(u32x4*)(lds + (buf) * 65536 + 32768 + sw + i * 8192) = rb[i]; } while (0)
#define FLOAD(fa, fb, co) do { _Pragma("unroll") for (int mb = 0; mb < MB; ++mb) fa[mb] = *(const bf16x8*)(base + aoff + mb * 4096 + (co)); \
    _Pragma("unroll") for (int nb = 0; nb < 2; ++nb) fb[nb] = *(const bf16x8*)(base + boff + nb * 4096 + (co)); } while (0)
#define FMMA(fa, fb) do { _Pragma("unroll") for (int mb = 0; mb < MB; ++mb) _Pragma("unroll") for (int nb = 0; nb < 2; ++nb) \
    acc[mb][nb] = __builtin_amdgcn_mfma_f32_32x32x16_bf16(fa[mb], fb[nb], acc[mb][nb], 0, 0, 0); } while (0)
  GLOAD(0); GWRITE(0); if (nk > 1) GLOAD(1); __syncthreads();
  for (int kt = 0; kt < nk; ++kt) {
    const int buf = kt & 1;
    const char* base = lds + buf * 65536;
    bf16x8 a0[MB], b0[2], a1[MB], b1[2];
    FLOAD(a0, b0, co0); SBAR();
    if (kt + 1 < nk) { GWRITE(buf ^ 1); if (kt + 2 < nk) GLOAD(kt + 2); } SBAR();
    FLOAD(a1, b1, co1); FMMA(a0, b0); SBAR();
    FLOAD(a0, b0, co2); FMMA(a1, b1); SBAR();
    FLOAD(a1, b1, co3); FMMA(a0, b0); SBAR();
    FMMA(a1, b1); SBAR();
    __syncthreads();
  }
#undef GLOAD
#undef GWRITE
#undef FLOAD
#undef FMMA
  epi.template operator()<MB>(acc, m0, n0, r32, hi);
}

struct EpiBf16 {
  bf16_t* O; int ldo; const float* rs;
  template <int MB> __device__ __forceinline__ void operator()(const f32x16 (&acc)[MB][2], int m0, int n0, int r32, int hi) const {
    unsigned base = (unsigned)((m0 + 4 * hi) * ldo + n0 + r32) * 2u; LAUNDER_V(base);
    int rbase = m0 + 4 * hi; LAUNDER_V(rbase);
    char* Ob = (char*)O;
#pragma unroll
    for (int mb = 0; mb < MB; ++mb)
#pragma unroll
      for (int r = 0; r < 16; ++r) {
        const int rr = mb * 32 + (r & 3) + 8 * (r >> 2);
        const float s = rs ? rs[rbase + rr] : 1.f;
        const unsigned off = base + (unsigned)(rr * ldo) * 2u;
        *(bf16_t*)(Ob + off) = f2bf(acc[mb][0][r] * s);
        *(bf16_t*)(Ob + off + 64) = f2bf(acc[mb][1][r] * s);
        if ((r & 7) == 7) SBAR();
      }
  }
};
struct EpiOut {
  const float* res; float* out; const float* g;
  template <int MB> __device__ __forceinline__ void operator()(const f32x16 (&acc)[MB][2], int m0, int n0, int r32, int hi) const {
    const float g0 = g[n0 + r32], g1 = g[n0 + 32 + r32];
    unsigned base = (unsigned)((m0 + 4 * hi) * 1024 + n0 + r32) * 4u; LAUNDER_V(base);
    const char* rb = (const char*)res; char* ob = (char*)out;
#pragma unroll
    for (int mb = 0; mb < MB; ++mb)
#pragma unroll
      for (int r = 0; r < 16; ++r) {
        const unsigned off = base + (unsigned)((mb * 32 + (r & 3) + 8 * (r >> 2)) * 4096);
        const float x0 = *(const float*)(rb + off), x1 = *(const float*)(rb + off + 128);
        *(float*)(ob + off) = ALPHA * x0 + g0 * acc[mb][0][r];
        *(float*)(ob + off + 128) = ALPHA * x1 + g1 * acc[mb][1][r];
        if ((r & 3) == 3) SBAR();
      }
  }
};

namespace g8 {
constexpr int BK = 64, HALF = 128, HT = HALF * BK;
__device__ __forceinline__ int lds_byte(int r, int c) { const int st = (r >> 4) * 2 + (c >> 5), rr = r & 15, cc = c & 31, ob = rr * 64 + cc * 2; return st * 1024 + (ob ^ (((ob >> 9) & 1) << 5)); }
__device__ __forceinline__ void stage_rc(int b, int& R, int& C) { const int st = b / 1024, sb = b % 1024, swz = sb ^ (((sb >> 9) & 1) << 5); R = (st >> 1) * 16 + swz / 64; C = (st & 1) * 32 + (swz % 64) / 2; }
template <class Epi>
__device__ __forceinline__ void gemm_tile8(const bf16_t* __restrict__ A, const bf16_t* __restrict__ Bt, int K, const Epi& epi, char* lds) {
  bf16_t* shm = (bf16_t*)lds;
  int tid = threadIdx.x; LAUNDER_V(tid);
#define SA(b, h) (shm + ((b) * 2 + (h)) * HT)
#define SB(b, h) (shm + (4 + (b) * 2 + (h)) * HT)
#define STAGE(Pp, BASE, br, kt) do { const long g_ = (long)(br) * K + (long)(kt) * BK; \
    _Pragma("unroll") for (int i_ = 0; i_ < 2; ++i_) { const int b_ = tid * 16 + i_ * 8192; int r_, c_; stage_rc(b_, r_, c_); \
      __builtin_amdgcn_global_load_lds((const unsigned*)(BASE + g_ + (long)r_ * K + c_), (unsigned*)((char*)(Pp) + b_), 16, 0, 0); } } while (0)
#define LDA(dst, b, h) _Pragma("unroll") for (int m = 0; m < 4; ++m) _Pragma("unroll") for (int k = 0; k < 2; ++k) \
    dst[m][k] = *reinterpret_cast<const bf16x8*>((char*)SA(b, h) + lds_byte(wr * 64 + m * 16 + fr, k * 32 + fq * 8))
#define LDB(dst, b, h) _Pragma("unroll") for (int n = 0; n < 2; ++n) _Pragma("unroll") for (int k = 0; k < 2; ++k) \
    dst[n][k] = *reinterpret_cast<const bf16x8*>((char*)SB(b, h) + lds_byte(wc * 32 + n * 16 + fr, k * 32 + fq * 8))
#define MMA(ai, bj, Af, Bf) do { __builtin_amdgcn_s_setprio(1); \
    _Pragma("unroll") for (int m = 0; m < 4; ++m) _Pragma("unroll") for (int n = 0; n < 2; ++n) _Pragma("unroll") for (int k = 0; k < 2; ++k) \
      acc[ai][bj][m][n] = __builtin_amdgcn_mfma_f32_16x16x32_bf16(Bf[n][k], Af[m][k], acc[ai][bj][m][n], 0, 0, 0); \
    __builtin_amdgcn_s_setprio(0); } while (0)
#define WAIT_V(n) asm volatile("s_waitcnt vmcnt(" #n ")" ::: "memory")
#define WAIT_L(n) asm volatile("s_waitcnt lgkmcnt(" #n ")" ::: "memory")
#define BAR __builtin_amdgcn_s_barrier()
#define SCHED __builtin_amdgcn_sched_barrier(0)
  const int wid = tid >> 6, lane = tid & 63, wr = wid >> 2, wc = wid & 3, fr = lane & 15, fq = lane >> 4;
  f32x4 acc[2][2][4][2];
#pragma unroll
  for (int a_ = 0; a_ < 2; ++a_)
#pragma unroll
    for (int b_ = 0; b_ < 2; ++b_)
#pragma unroll
      for (int m = 0; m < 4; ++m) { acc[a_][b_][m][0] = f32x4{0.f, 0.f, 0.f, 0.f}; acc[a_][b_][m][1] = f32x4{0.f, 0.f, 0.f, 0.f}; }
  bf16x8 At[4][2], B0[2][2], B1[2][2];
  const int nt = K / BK;
  WAIT_V(0); __syncthreads();
  STAGE(SB(0, 0), Bt, 0, 0); STAGE(SA(0, 0), A, 0, 0);
  STAGE(SB(0, 1), Bt, HALF, 0); STAGE(SA(0, 1), A, HALF, 0);
  if (wr == 1) BAR;
  WAIT_V(4); BAR;
  STAGE(SB(1, 0), Bt, 0, 1); STAGE(SA(1, 0), A, 0, 1); STAGE(SB(1, 1), Bt, HALF, 1);
  WAIT_V(6); BAR;
  for (int t = 0; t < nt - 2; t += 2) {
    LDB(B0, 0, 0); SCHED; LDA(At, 0, 0); STAGE(SA(1, 1), A, HALF, t + 1);
    WAIT_L(8); BAR; WAIT_L(0); MMA(0, 0, At, B0); BAR; SCHED;
    LDB(B1, 0, 1); STAGE(SB(0, 0), Bt, 0, t + 2);
    BAR; WAIT_L(0); MMA(0, 1, At, B1); BAR;
    LDA(At, 0, 1); STAGE(SA(0, 0), A, 0, t + 2);
    BAR; WAIT_L(0); MMA(1, 0, At, B0); BAR; SCHED;
    STAGE(SB(0, 1), Bt, HALF, t + 2);
    WAIT_V(6); BAR; MMA(1, 1, At, B1); BAR;
    LDB(B0, 1, 0); SCHED; LDA(At, 1, 0); STAGE(SA(0, 1), A, HALF, t + 2);
    WAIT_L(8); BAR; WAIT_L(0); MMA(0, 0, At, B0); BAR; SCHED;
    LDB(B1, 1, 1); STAGE(SB(1, 0), Bt, 0, t + 3);
    BAR; WAIT_L(0); MMA(0, 1, At, B1); BAR;
    LDA(At, 1, 1); STAGE(SA(1, 0), A, 0, t + 3);
    BAR; WAIT_L(0); MMA(1, 0, At, B0); BAR; SCHED;
    STAGE(SB(1, 1), Bt, HALF, t + 3);
    WAIT_V(6); BAR; MMA(1, 1, At, B1); BAR;
  }
  { LDB(B0, 0, 0); LDA(At, 0, 0); STAGE(SA(1, 1), A, HALF, nt - 1);
    BAR; WAIT_L(0); MMA(0, 0, At, B0); BAR;
    LDB(B1, 0, 1); BAR; WAIT_L(0); MMA(0, 1, At, B1); BAR;
    LDA(At, 0, 1); WAIT_V(4); BAR; WAIT_L(0); MMA(1, 0, At, B0); MMA(1, 1, At, B1); BAR; }
  { LDB(B0, 1, 0); LDA(At, 1, 0); WAIT_V(2); BAR; WAIT_L(0); MMA(0, 0, At, B0); BAR;
    LDB(B1, 1, 1); WAIT_V(0); BAR; WAIT_L(0); MMA(0, 1, At, B1); BAR;
    LDA(At, 1, 1); BAR; WAIT_L(0); MMA(1, 0, At, B0); MMA(1, 1, At, B1); BAR; }
  if (wr == 0) BAR;
#undef SA
#undef SB
#undef STAGE
#undef LDA
#undef LDB
#undef MMA
#undef WAIT_V
#undef WAIT_L
#undef BAR
#undef SCHED
  epi(acc, wr, wc, fr, fq);
}
struct EpiBf16 {
  bf16_t* O; int ldo;
  __device__ __forceinline__ void operator()(const f32x4 (&acc)[2][2][4][2], int wr, int wc, int fr, int fq) const {
    unsigned base = (unsigned)((wr * 64 + fr) * ldo + wc * 32 + fq * 4) * 2u; LAUNDER_V(base);
    char* Ob = (char*)O;
#pragma unroll
    for (int ai = 0; ai < 2; ++ai)
#pragma unroll
      for (int m = 0; m < 4; ++m) {
        const unsigned ro = base + (unsigned)((ai * 128 + m * 16) * ldo) * 2u;
#pragma unroll
        for (int bj = 0; bj < 2; ++bj)
#pragma unroll
          for (int n = 0; n < 2; ++n) {
            const f32x4 v = acc[ai][bj][m][n];
            u32x2 w; w.x = cvtpk(v[0], v[1]); w.y = cvtpk(v[2], v[3]);
            *(u32x2*)(Ob + ro + (bj * 128 + n * 16) * 2) = w;
          }
        SBAR();
      }
  }
};
struct EpiOut {
  const float* res; float* out; const float* g;
  __device__ __forceinline__ void operator()(const f32x4 (&acc)[2][2][4][2], int wr, int wc, int fr, int fq) const {
    unsigned base = (unsigned)((wr * 64 + fr) * 1024 + wc * 32 + fq * 4) * 4u; LAUNDER_V(base);
    const char* rb = (const char*)res; char* ob = (char*)out;
    f32x4 gv[2][2];
#pragma unroll
    for (int bj = 0; bj < 2; ++bj)
#pragma unroll
      for (int n = 0; n < 2; ++n) gv[bj][n] = *(const f32x4*)(g + bj * 128 + wc * 32 + n * 16 + fq * 4);
#pragma unroll
    for (int ai = 0; ai < 2; ++ai)
#pragma unroll
      for (int m = 0; m < 4; ++m) {
        const unsigned ro = base + (unsigned)((ai * 128 + m * 16) * 4096);
#pragma unroll
        for (int bj = 0; bj < 2; ++bj)
#pragma unroll
          for (int n = 0; n < 2; ++n) {
            const unsigned o_ = ro + (bj * 128 + n * 16) * 4;
            const f32x4 x = *(const f32x4*)(rb + o_);
            *(f32x4*)(ob + o_) = x * ALPHA + gv[bj][n] * acc[ai][bj][m][n];
          }
        SBAR();
      }
  }
};
}

__device__ __forceinline__ void tile_order(int L, int nM, int nN, int& pm, int& pn) {
  const int nwg = nM * nN, q = nwg >> 3, r = nwg & 7, xcd = L & 7, off = L >> 3;
  const int wgid = (xcd < r ? xcd * (q + 1) : r * (q + 1) + (xcd - r) * q) + off;
  const int nig = 8 * nN, gid = wgid / nig, fm = gid * 8, gsz = (nM - fm) < 8 ? (nM - fm) : 8;
  pm = fm + ((wgid % nig) % gsz); pn = (wgid % nig) / gsz;
}
__device__ __forceinline__ void phase_gemm1(const P& p, int layer, char* lds) {
  const int npad = layer == 0 ? NPAD0 : layer == 1 ? NPAD1 : layer == 2 ? NPAD2 : NPAD3;
  const size_t woff = layer == 0 ? WS_WIN0 : layer == 1 ? WS_WIN1 : layer == 2 ? WS_WIN2 : WS_WIN3;
  const bf16_t* A = (const bf16_t*)(p.ws + WS_ABUF);
  const bf16_t* W = (const bf16_t*)(p.ws + woff);
  bf16_t* O = (bf16_t*)(p.ws + WS_PROJ);
  const int nN = npad / 256, nt = 128 * nN;
  for (int t = blockIdx.x; t < nt; t += gridDim.x) {
    int pl, pn; tile_order(t, 128, nN, pl, pn); const int pm = pl + pl / 64;
    g8::EpiBf16 e{O + (size_t)pm * 256 * npad + pn * 256, npad};
    g8::gemm_tile8(A + (size_t)pm * 256 * 1024, W + (size_t)pn * 256 * 1024, 1024, e, lds);
  }
  for (int u = gridDim.x - 1 - blockIdx.x; u < 8 * nN; u += gridDim.x) {
    const int q = u / nN, pn = u % nN; const size_t row0 = (size_t)(q >> 2) * TPB + SEQ + (q & 3) * 64;
    EpiBf16 e{O + row0 * npad + pn * 256, npad, nullptr};
    gemm_tile<1>(A + row0 * 1024, 1024, W + (size_t)pn * 256 * 1024, 1024, 1024, e, lds);
  }
}

__device__ __forceinline__ void phase_gemm2(const P& p, char* lds) {
  const bf16_t* P1 = (const bf16_t*)(p.ws + WS_PROJ);
  float* rs = (float*)(lds + 131072);
  int tid = threadIdx.x; LAUNDER_V(tid);
  for (int t = blockIdx.x; t < 130 * 14; t += gridDim.x) {
    const int pm = t / 14, j = t % 14;
    const bool isq = j < 6; const int pn = isq ? j : j - 6;
    const int KK = isq ? 256 : 128, acol = isq ? 0 : 256;
    const bf16_t* A = P1 + (size_t)pm * 256 * 1536 + acol;
    {
      const int r = tid >> 1, half = tid & 1;
      const bf16_t* ap = A + (size_t)r * 1536 + half * (KK / 2);
      float ss = 0.f;
      for (int i = 0; i < KK / 16; ++i) { const bf16x8 v = *(const bf16x8*)(ap + i * 8);
#pragma unroll
        for (int e = 0; e < 8; ++e) { const float f = bf2f(v[e]); ss += f * f; } }
      ss += __shfl_xor(ss, 1);
      if (!half) rs[r] = rsqrtf(ss / (float)KK + EPS);
    }
    __syncthreads();
    if (isq) {
      EpiBf16 e{(bf16_t*)(p.ws + WS_X) + (size_t)pm * 256 * 1536 + pn * 256, 1536, rs};
      gemm_tile<4>(A, 1536, (const bf16_t*)(p.ws + WS_WQB) + (size_t)pn * 256 * 256, 256, 256, e, lds);
    } else {
      EpiBf16 e{(bf16_t*)(p.ws + WS_KV2) + (size_t)pm * 256 * 2048 + pn * 256, 2048, rs};
      gemm_tile<4>(A, 1536, (const bf16_t*)(p.ws + WS_WKVB) + (size_t)pn * 256 * 128, 128, 128, e, lds);
    }
    __syncthreads();
  }
}

__device__ __forceinline__ void phase_outproj(const P& p, int layer, char* lds) {
  const bf16_t* A = (const bf16_t*)(p.ws + WS_ABUF);
  const bf16_t* W = (const bf16_t*)(p.ws + WS_WOUT) + (size_t)layer * 1024 * 1024;
  float* X = (float*)(p.ws + WS_X);
  const float* mod = (const float*)(p.ws + WS_MOD) + layer * 3 * 3072;
  for (int t = blockIdx.x; t < 128 * 4; t += gridDim.x) {
    int pl, pn; tile_order(t, 128, 4, pl, pn); const int pm = pl + pl / 64; const int b = pm / 65, lt = pm % 65;
    const float* res = layer == 0 ? p.x + ((size_t)b * SEQ + lt * 256) * 1024 : X + (size_t)pm * 256 * 1024;
    g8::EpiOut e{res + pn * 256, X + (size_t)pm * 256 * 1024 + pn * 256, mod + b * 3072 + 2048 + pn * 256};
    g8::gemm_tile8(A + (size_t)pm * 256 * 1024, W + (size_t)pn * 256 * 1024, 1024, e, lds);
  }
  if (layer < 3) {
    for (int u = blockIdx.x; u < 32; u += gridDim.x) {
      const int q = u >> 2, pn = u & 3; const int b = q >> 2; const size_t row0 = (size_t)b * TPB + SEQ + (q & 3) * 64;
      const float* res = layer == 0 ? p.ctx + ((size_t)b * CTXL + (q & 3) * 64) * 1024 : X + row0 * 1024;
      EpiOut e{res + pn * 256, X + row0 * 1024 + pn * 256, mod + 2 * 3072 + 2048 + pn * 256};
      gemm_tile<1>(A + row0 * 1024, 1024, W + (size_t)pn * 256 * 1024, 1024, 1024, e, lds);
    }
  }
}

__device__ __forceinline__ void phase_ln(const P& p, int layer) {
  float* X = (float*)(p.ws + WS_X);
  bf16_t* hb = (bf16_t*)(p.ws + WS_ABUF);
  const float* g = p.ln_g + layer * 1024; const float* bb = p.ln_b + layer * 1024;
  const float* modn = (const float*)(p.ws + WS_MOD) + (layer + 1) * 3 * 3072;
  const bool last = layer == 3;
  int tid = threadIdx.x; LAUNDER_V(tid);
  const int wid = tid >> 6, lane = tid & 63;
  for (int row = blockIdx.x * 8 + wid; row < NROW; row += gridDim.x * 8) {
    const int b = row / TPB, t = row % TPB;
    if (last && t >= SEQ) continue;
    float* xr = X + (size_t)row * 1024;
    f32x4 v[4]; float s = 0.f;
#pragma unroll
    for (int j = 0; j < 4; ++j) { v[j] = *(const f32x4*)(xr + j * 256 + lane * 4); s += (v[j][0] + v[j][1]) + (v[j][2] + v[j][3]); }
#pragma unroll
    for (int o = 32; o >= 1; o >>= 1) s += __shfl_xor(s, o);
    const float mean = s * (1.f / 1024.f); float q = 0.f;
#pragma unroll
    for (int j = 0; j < 4; ++j) { v[j] = v[j] - mean; q += (v[j][0] * v[j][0] + v[j][1] * v[j][1]) + (v[j][2] * v[j][2] + v[j][3] * v[j][3]); }
#pragma unroll
    for (int o = 32; o >= 1; o >>= 1) q += __shfl_xor(q, o);
    const float rstd = rsqrtf(q * (1.f / 1024.f) + EPS);
    const int vsel = t < SEQ ? b : 2;
    float* dst = last ? p.out + ((size_t)b * SEQ + t) * 1024 : xr;
#pragma unroll
    for (int j = 0; j < 4; ++j) {
      const int col = j * 256 + lane * 4;
      const f32x4 gg = *(const f32x4*)(g + col), be = *(const f32x4*)(bb + col);
      f32x4 y = v[j] * rstd * gg + be;
      *(f32x4*)(dst + col) = y;
      if (!last) {
        const f32x4 sh = *(const f32x4*)(modn + vsel * 3072 + col), sc = *(const f32x4*)(modn + vsel * 3072 + 1024 + col);
        u32x2 w; w.x = cvtpk(y[0] * (1.f + sc[0]) + sh[0], y[1] * (1.f + sc[1]) + sh[1]); w.y = cvtpk(y[2] * (1.f + sc[2]) + sh[2], y[3] * (1.f + sc[3]) + sh[3]);
        *(u32x2*)(hb + (size_t)row * 1024 + col) = w;
      }
    }
  }
}

__device__ __forceinline__ void unpack8(bf16x8 v, float (&f)[8]) {
#pragma unroll
  for (int e = 0; e < 8; ++e) f[e] = bf2f(v[e]);
}
__device__ __forceinline__ bf16x8 pack8(const float (&f)[8]) {
  u32x4 w = {cvtpk(f[0], f[1]), cvtpk(f[2], f[3]), cvtpk(f[4], f[5]), cvtpk(f[6], f[7])}; return *reinterpret_cast<bf16x8*>(&w);
}
__device__ __forceinline__ void rope8f(float (&x1)[8], float (&x2)[8], const float* cs, const float* sn) {
  const f32x4 c0 = *(const f32x4*)cs, c1 = *(const f32x4*)(cs + 4), s0 = *(const f32x4*)sn, s1 = *(const f32x4*)(sn + 4);
#pragma unroll
  for (int e = 0; e < 8; ++e) {
    const float c = e < 4 ? c0[e & 3] : c1[e & 3], s = e < 4 ? s0[e & 3] : s1[e & 3];
    const float a = x1[e], b = x2[e];
    x1[e] = a * c - b * s; x2[e] = b * c + a * s;
  }
}
__device__ __forceinline__ void rope8(bf16x8& a, bf16x8& b, const float* cs, const float* sn) {
  float x1[8], x2[8]; unpack8(a, x1); unpack8(b, x2); rope8f(x1, x2, cs, sn); a = pack8(x1); b = pack8(x2);
}

template <int KIND>
__device__ __forceinline__ void phase_kfix(const P& p) {
  constexpr int HD = KIND == 0 ? 32 : KIND == 2 ? 128 : 64;
  constexpr int UPR = KIND == 0 ? 1 : KIND == 1 ? 16 : 2;
  constexpr int G = HD / 16, NF = HD / 4;
  constexpr int LD = KIND == 0 ? NPAD0 : KIND == 1 ? NPAD1 : KIND == 2 ? NPAD2 : NPAD3;
  constexpr int BASE = KIND == 0 ? 384 : 1024;
  constexpr int ROFF = KIND == 0 ? ROPE32_OFF : KIND == 2 ? ROPE128_OFF : ROPE64_OFF;
  bf16_t* proj = (bf16_t*)(p.ws + WS_PROJ);
  const float* rt = (const float*)(p.ws + WS_ROPE) + ROFF;
  const size_t total = (size_t)NROW * UPR * G;
  int tid = threadIdx.x; LAUNDER_V(tid);
  for (size_t i = (size_t)blockIdx.x * NTHR + tid; i < total; i += (size_t)gridDim.x * NTHR) {
    const int sub = (int)(i % G); const size_t u = i / G; const int head = (int)(u % UPR); const int row = (int)(u / UPR);
    const int t = row % TPB; const bool latent = t < SEQ;
    if (KIND != 2 && !latent) continue;
    bf16_t* ptr = proj + (size_t)row * LD + BASE + head * HD + sub * 8;
    float x1[8], x2[8];
    unpack8(*(const bf16x8*)ptr, x1); unpack8(*(const bf16x8*)(ptr + HD / 2), x2);
    if (KIND == 2) {
      float ss = 0.f;
#pragma unroll
      for (int e = 0; e < 8; ++e) ss += x1[e] * x1[e] + x2[e] * x2[e];
      ss += __shfl_xor(ss, 1); ss += __shfl_xor(ss, 2); ss += __shfl_xor(ss, 4);
      const float rstd = rsqrtf(ss * (1.f / 128.f) + EPS);
#pragma unroll
      for (int e = 0; e < 8; ++e) { x1[e] *= rstd * p.gqa_g_k[sub * 8 + e]; x2[e] *= rstd * p.gqa_g_k[64 + sub * 8 + e]; }
    }
    if (latent) {
      const bool isrow = sub * 8 < NF; const int f0 = isrow ? sub * 8 : sub * 8 - NF; const int pos = isrow ? (t >> 6) : (t & 63);
      rope8f(x1, x2, rt + pos * NF + f0, rt + 256 * NF + pos * NF + f0);
    }
    *(bf16x8*)ptr = pack8(x1); *(bf16x8*)(ptr + HD / 2) = pack8(x2);
  }
}

template <int NCB> __device__ __forceinline__ int v_st(int k, int c) { const int kk = k;     return ((kk >> 3) * NCB + (c >> 5)) * 512 + ((kk & 7) * 32 + (c & 31)) * 2; }
__device__ __forceinline__ int v_rd_base(int lane) { return ((lane & 3) << 3) | (((lane >> 2) & 3) << 6) | (((lane >> 4) & 1) << 5) | (((lane >> 5) & 1) << 8); }
template <int OFF> __device__ __forceinline__ s16x4 tr_read(int vb) {
  s16x4 r; asm volatile("ds_read_b64_tr_b16 %0, %1 offset:%2" : "=&v"(r) : "v"(vb), "i"(OFF) : "memory"); return r;
}
template <int NCB, int D0> __device__ __forceinline__ void pv_one(f32x16& od, int vb, bf16x8 pa0, bf16x8 pa1, bf16x8 pa2, bf16x8 pa3) {
#define VOFF(ks, half) (((2 * (ks) + (half)) * NCB + D0) * 512)
  const s16x4 l0 = tr_read<VOFF(0, 0)>(vb), h0 = tr_read<VOFF(0, 1)>(vb), l1 = tr_read<VOFF(1, 0)>(vb), h1 = tr_read<VOFF(1, 1)>(vb);
  const s16x4 l2 = tr_read<VOFF(2, 0)>(vb), h2 = tr_read<VOFF(2, 1)>(vb), l3 = tr_read<VOFF(3, 0)>(vb), h3 = tr_read<VOFF(3, 1)>(vb);
#undef VOFF
  asm volatile("s_waitcnt lgkmcnt(0)" ::: "memory"); SBAR();
#define PK(L, H) (bf16x8){L[0], L[1], L[2], L[3], H[0], H[1], H[2], H[3]}
  od = __builtin_amdgcn_mfma_f32_32x32x16_bf16(pa0, PK(l0, h0), od, 0, 0, 0);
  od = __builtin_amdgcn_mfma_f32_32x32x16_bf16(pa1, PK(l1, h1), od, 0, 0, 0);
  od = __builtin_amdgcn_mfma_f32_32x32x16_bf16(pa2, PK(l2, h2), od, 0, 0, 0);
  od = __builtin_amdgcn_mfma_f32_32x32x16_bf16(pa3, PK(l3, h3), od, 0, 0, 0);
#undef PK
}
template <int NCB, int KS> __device__ __forceinline__ void v_reads_ks(s16x4 (&v)[8], int vb) {
#define VOFF(d, half) (((2 * KS + (half)) * NCB + (d)) * 512)
  v[0] = tr_read<VOFF(0, 0)>(vb); v[1] = tr_read<VOFF(0, 1)>(vb); v[2] = tr_read<VOFF(1, 0)>(vb); v[3] = tr_read<VOFF(1, 1)>(vb);
  v[4] = tr_read<VOFF(2, 0)>(vb); v[5] = tr_read<VOFF(2, 1)>(vb); v[6] = tr_read<VOFF(3, 0)>(vb); v[7] = tr_read<VOFF(3, 1)>(vb);
#undef VOFF
}
__device__ __forceinline__ void pv_mm_ks(f32x16 (&o)[4], const s16x4 (&v)[8], bf16x8 pa) {
#define PK(L, H) (bf16x8){L[0], L[1], L[2], L[3], H[0], H[1], H[2], H[3]}
  o[0] = __builtin_amdgcn_mfma_f32_32x32x16_bf16(pa, PK(v[0], v[1]), o[0], 0, 0, 0);
  o[1] = __builtin_amdgcn_mfma_f32_32x32x16_bf16(pa, PK(v[2], v[3]), o[1], 0, 0, 0);
  o[2] = __builtin_amdgcn_mfma_f32_32x32x16_bf16(pa, PK(v[4], v[5]), o[2], 0, 0, 0);
  o[3] = __builtin_amdgcn_mfma_f32_32x32x16_bf16(pa, PK(v[6], v[7]), o[3], 0, 0, 0);
#undef PK
}
template <int NCB> __device__ __forceinline__ void pv_all(f32x16 (&o)[NCB], int vb, bf16x8 pa0, bf16x8 pa1, bf16x8 pa2, bf16x8 pa3) {
  if constexpr (NCB == 4) {
    s16x4 va[8], vc[8];
    v_reads_ks<4, 0>(va, vb);
    v_reads_ks<4, 1>(vc, vb); asm volatile("s_waitcnt lgkmcnt(8)" ::: "memory"); SBAR(); pv_mm_ks(o, va, pa0);
    v_reads_ks<4, 2>(va, vb); asm volatile("s_waitcnt lgkmcnt(8)" ::: "memory"); SBAR(); pv_mm_ks(o, vc, pa1);
    v_reads_ks<4, 3>(vc, vb); asm volatile("s_waitcnt lgkmcnt(8)" ::: "memory"); SBAR(); pv_mm_ks(o, va, pa2);
    asm volatile("s_waitcnt lgkmcnt(0)" ::: "memory"); SBAR(); pv_mm_ks(o, vc, pa3);
  } else {
    pv_one<NCB, 0>(o[0], vb, pa0, pa1, pa2, pa3); pv_one<NCB, 1>(o[1], vb, pa0, pa1, pa2, pa3);
  }
}

constexpr float THR = 8.f;
template <int DQK> struct ScaleOf { static constexpr float v = DQK == 64 ? 0.125f : DQK == 96 ? 0.10206207261596575f : 0.08838834764831845f; };

template <int DQK>
__device__ __forceinline__ void partialSM(f32x16& p0, f32x16& p1, float& m_reg, float& mn, float& alpha) {
  constexpr float SCALE = ScaleOf<DQK>::v, C = SCALE * LOG2E;
  float pmax = p0[0];
#pragma unroll
  for (int r = 1; r < 16; ++r) pmax = fmaxf(pmax, p0[r]);
#pragma unroll
  for (int r = 0; r < 16; ++r) pmax = fmaxf(pmax, p1[r]);
  { auto rr = __builtin_amdgcn_permlane32_swap(__float_as_uint(pmax), __float_as_uint(pmax), false, false);
    pmax = fmaxf(__uint_as_float(rr[0]), __uint_as_float(rr[1])); }
  if (__builtin_expect(__all(pmax - m_reg <= THR / SCALE), 1)) { mn = m_reg; alpha = 1.f; }
  else { mn = fmaxf(m_reg, pmax); alpha = __builtin_amdgcn_exp2f((m_reg - mn) * C); m_reg = mn; }
  const float mnC = -mn * C;
#pragma unroll
  for (int r = 0; r < 16; ++r) p0[r] = fmaf(p0[r], C, mnC);
#pragma unroll
  for (int r = 0; r < 16; ++r) p1[r] = fmaf(p1[r], C, mnC);
#pragma unroll
  for (int r = 0; r < 16; ++r) p0[r] = __builtin_amdgcn_exp2f(p0[r]);
}
__device__ __forceinline__ void finishSM(f32x16& p0, f32x16& p1, float alpha, float& l_reg, bf16x8& pa0, bf16x8& pa1, bf16x8& pa2, bf16x8& pa3) {
#pragma unroll
  for (int r = 0; r < 16; ++r) p1[r] = __builtin_amdgcn_exp2f(p1[r]);
  float ps = 0;
#pragma unroll
  for (int r = 0; r < 16; ++r) ps += p0[r];
#pragma unroll
  for (int r = 0; r < 16; ++r) ps += p1[r];
  { auto rr = __builtin_amdgcn_permlane32_swap(__float_as_uint(ps), __float_as_uint(ps), false, false);
    ps = __uint_as_float(rr[0]) + __uint_as_float(rr[1]); }
  l_reg = l_reg * alpha + ps;
#define PK4(Pv, BASE, OUT) do { unsigned a0 = cvtpk(Pv[BASE + 0], Pv[BASE + 1]), a1 = cvtpk(Pv[BASE + 2], Pv[BASE + 3]);   \
    unsigned b0 = cvtpk(Pv[BASE + 4], Pv[BASE + 5]), b1 = cvtpk(Pv[BASE + 6], Pv[BASE + 7]);                              \
    auto r0 = __builtin_amdgcn_permlane32_swap(a0, b0, false, false); auto r1 = __builtin_amdgcn_permlane32_swap(a1, b1, false, false); \
    u32x4 w = {r0[0], r1[0], r0[1], r1[1]}; OUT = *reinterpret_cast<bf16x8*>(&w); } while (0)
  PK4(p0, 0, pa0); PK4(p0, 8, pa1); PK4(p1, 0, pa2); PK4(p1, 8, pa3);
#undef PK4
}
template <int DQK>
__device__ __forceinline__ void qkt(f32x16& p0, f32x16& p1, const char* Ks, const bf16x8 (&qr)[DQK / 16], int r32, int hi) {
  constexpr int KSTR = DQK * 2 + 16;
  p0 = f32x16{}; p1 = f32x16{};
#pragma unroll
  for (int d0 = 0; d0 < DQK / 16; ++d0) { const int cb = (d0 * 16 + hi * 8) * 2;
    const bf16x8 b0 = *reinterpret_cast<const bf16x8*>(Ks + r32 * KSTR + cb);
    const bf16x8 b1 = *reinterpret_cast<const bf16x8*>(Ks + (32 + r32) * KSTR + cb);
    p0 = __builtin_amdgcn_mfma_f32_32x32x16_bf16(b0, qr[d0], p0, 0, 0, 0);
    p1 = __builtin_amdgcn_mfma_f32_32x32x16_bf16(b1, qr[d0], p1, 0, 0, 0); }
}
__device__ __forceinline__ void swa_mask(f32x16& p0, f32x16& p1, int kp0, int qpos, int hi) {
  const float ninf = -__builtin_inff();
#pragma unroll
  for (int r = 0; r < 16; ++r) {
    const int d0 = kp0 + crow(r, hi) - qpos, d1 = d0 + 32;
    if (d0 > 128 || d0 < -128) p0[r] = ninf;
    if (d1 > 128 || d1 < -128) p1[r] = ninf;
  }
}

template <int OFF> __device__ __forceinline__ bf16x8 lds_rd128(int a) {
  bf16x8 r; asm volatile("ds_read_b128 %0, %1 offset:%2" : "=&v"(r) : "v"(a), "i"(OFF) : "memory"); return r;
}
#define WAITL(n) do { asm volatile("s_waitcnt lgkmcnt(" #n ")" ::: "memory"); SBAR(); } while (0)
template <int NCB, int D0> __device__ __forceinline__ void v_reads(s16x4 (&v)[8], int vb) {
#define VOFF(ks, half) (((2 * (ks) + (half)) * NCB + D0) * 512)
  v[0] = tr_read<VOFF(0, 0)>(vb); v[1] = tr_read<VOFF(0, 1)>(vb); v[2] = tr_read<VOFF(1, 0)>(vb); v[3] = tr_read<VOFF(1, 1)>(vb);
  v[4] = tr_read<VOFF(2, 0)>(vb); v[5] = tr_read<VOFF(2, 1)>(vb); v[6] = tr_read<VOFF(3, 0)>(vb); v[7] = tr_read<VOFF(3, 1)>(vb);
#undef VOFF
}
__device__ __forceinline__ void pv_mm(f32x16& od, const s16x4 (&v)[8], bf16x8 pa0, bf16x8 pa1, bf16x8 pa2, bf16x8 pa3) {
#define PK(L, H) (bf16x8){L[0], L[1], L[2], L[3], H[0], H[1], H[2], H[3]}
  od = __builtin_amdgcn_mfma_f32_32x32x16_bf16(pa0, PK(v[0], v[1]), od, 0, 0, 0);
  od = __builtin_amdgcn_mfma_f32_32x32x16_bf16(pa1, PK(v[2], v[3]), od, 0, 0, 0);
  od = __builtin_amdgcn_mfma_f32_32x32x16_bf16(pa2, PK(v[4], v[5]), od, 0, 0, 0);
  od = __builtin_amdgcn_mfma_f32_32x32x16_bf16(pa3, PK(v[6], v[7]), od, 0, 0, 0);
#undef PK
}
template <int DQK, int DV, bool DOQK>
__device__ __forceinline__ void mseg_body(f32x16& p0, f32x16& p1, f32x16 (&o)[DV / 32], const bf16x8 (&qr)[DQK / 16], int ka, int vb,
                                          bf16x8 pa0, bf16x8 pa1, bf16x8 pa2, bf16x8 pa3) {
  constexpr int NCB = DV / 32, KSTR = DQK * 2 + 16, R2 = 32 * KSTR;
  s16x4 va[8], vc[8];
#define QK2(KA, KB, D) do { p0 = __builtin_amdgcn_mfma_f32_32x32x16_bf16(KA, qr[D], p0, 0, 0, 0); p1 = __builtin_amdgcn_mfma_f32_32x32x16_bf16(KB, qr[D], p1, 0, 0, 0); } while (0)
  if constexpr (!DOQK) {
    v_reads<NCB, 0>(va, vb); v_reads<NCB, 1>(vc, vb);
  } else if constexpr (DQK == 64) {
    const bf16x8 k0 = lds_rd128<0>(ka), k1 = lds_rd128<R2>(ka), k2 = lds_rd128<32>(ka), k3 = lds_rd128<R2 + 32>(ka);
    const bf16x8 k4 = lds_rd128<64>(ka), k5 = lds_rd128<R2 + 64>(ka), k6 = lds_rd128<96>(ka), k7 = lds_rd128<R2 + 96>(ka);
    v_reads<NCB, 0>(va, vb); WAITL(8);
    v_reads<NCB, 1>(vc, vb);
    p0 = f32x16{}; p1 = f32x16{};
    QK2(k0, k1, 0); QK2(k2, k3, 1); QK2(k4, k5, 2); QK2(k6, k7, 3);
  } else if constexpr (DQK == 96) {
    const bf16x8 k0 = lds_rd128<0>(ka), k1 = lds_rd128<R2>(ka), k2 = lds_rd128<32>(ka), k3 = lds_rd128<R2 + 32>(ka), k4 = lds_rd128<64>(ka), k5 = lds_rd128<R2 + 64>(ka);
    const bf16x8 k6 = lds_rd128<96>(ka), k7 = lds_rd128<R2 + 96>(ka), k8 = lds_rd128<128>(ka), k9 = lds_rd128<R2 + 128>(ka), k10 = lds_rd128<160>(ka), k11 = lds_rd128<R2 + 160>(ka);
    WAITL(6);
    v_reads<NCB, 0>(va, vb);
    p0 = f32x16{}; p1 = f32x16{};
    QK2(k0, k1, 0); QK2(k2, k3, 1); QK2(k4, k5, 2);
    WAITL(8);
    v_reads<NCB, 1>(vc, vb);
    QK2(k6, k7, 3); QK2(k8, k9, 4); QK2(k10, k11, 5);
  } else {
    const bf16x8 k0 = lds_rd128<0>(ka), k1 = lds_rd128<R2>(ka), k2 = lds_rd128<32>(ka), k3 = lds_rd128<R2 + 32>(ka);
    const bf16x8 k4 = lds_rd128<64>(ka), k5 = lds_rd128<R2 + 64>(ka), k6 = lds_rd128<96>(ka), k7 = lds_rd128<R2 + 96>(ka);
    v_reads<NCB, 0>(va, vb); WAITL(8);
    p0 = f32x16{}; p1 = f32x16{};
    QK2(k0, k1, 0); QK2(k2, k3, 1); QK2(k4, k5, 2); QK2(k6, k7, 3);
    const bf16x8 j0 = lds_rd128<128>(ka), j1 = lds_rd128<R2 + 128>(ka), j2 = lds_rd128<160>(ka), j3 = lds_rd128<R2 + 160>(ka);
    const bf16x8 j4 = lds_rd128<192>(ka), j5 = lds_rd128<R2 + 192>(ka), j6 = lds_rd128<224>(ka), j7 = lds_rd128<R2 + 224>(ka);
    v_reads<NCB, 1>(vc, vb); WAITL(8);
    QK2(j0, j1, 4); QK2(j2, j3, 5); QK2(j4, j5, 6); QK2(j6, j7, 7);
  }
#undef QK2
  if constexpr (NCB == 4) {
    WAITL(8); pv_mm(o[0], va, pa0, pa1, pa2, pa3);
    v_reads<NCB, 2>(va, vb); WAITL(8); pv_mm(o[1], vc, pa0, pa1, pa2, pa3);
    v_reads<NCB, 3>(vc, vb); WAITL(8); pv_mm(o[2], va, pa0, pa1, pa2, pa3);
    WAITL(0); pv_mm(o[3], vc, pa0, pa1, pa2, pa3);
  } else {
    WAITL(8); pv_mm(o[0], va, pa0, pa1, pa2, pa3);
    WAITL(0); pv_mm(o[1], vc, pa0, pa1, pa2, pa3);
  }
}

template <int DQK, bool FAST>
__device__ __forceinline__ void softmax_tile(f32x16& p0, f32x16& p1, float& m_reg, float& l_reg, float& alpha, bf16x8& pa0, bf16x8& pa1, bf16x8& pa2, bf16x8& pa3) {
  constexpr float SCALE = ScaleOf<DQK>::v, C = SCALE * LOG2E;
  if constexpr (FAST) {
#pragma unroll
    for (int r = 0; r < 16; ++r) p0[r] = __builtin_amdgcn_exp2f(p0[r]);
#pragma unroll
    for (int r = 0; r < 16; ++r) p1[r] = __builtin_amdgcn_exp2f(p1[r]);
  } else {
  float pmax = p0[0];
#pragma unroll
  for (int r = 1; r < 16; ++r) pmax = fmaxf(pmax, p0[r]);
#pragma unroll
  for (int r = 0; r < 16; ++r) pmax = fmaxf(pmax, p1[r]);
  { auto rr = __builtin_amdgcn_permlane32_swap(__float_as_uint(pmax), __float_as_uint(pmax), false, false);
    pmax = fmaxf(__uint_as_float(rr[0]), __uint_as_float(rr[1])); }
  const bool any = __any((pmax - m_reg) > THR / SCALE);
  const float mn = any ? fmaxf(m_reg, pmax) : m_reg;
  alpha = __builtin_amdgcn_exp2f((m_reg - mn) * C);
  m_reg = mn;
  const float mnC = -mn * C;
#pragma unroll
  for (int r = 0; r < 16; ++r) p0[r] = __builtin_amdgcn_exp2f(fmaf(p0[r], C, mnC));
#pragma unroll
  for (int r = 0; r < 16; ++r) p1[r] = __builtin_amdgcn_exp2f(fmaf(p1[r], C, mnC));
  }
  float ps = 0;
#pragma unroll
  for (int r = 0; r < 16; ++r) ps += p0[r];
#pragma unroll
  for (int r = 0; r < 16; ++r) ps += p1[r];
  { auto rr = __builtin_amdgcn_permlane32_swap(__float_as_uint(ps), __float_as_uint(ps), false, false);
    ps = __uint_as_float(rr[0]) + __uint_as_float(rr[1]); }
  if constexpr (FAST) l_reg += ps; else l_reg = l_reg * alpha + ps;
#define PK4(Pv, BASE, OUT) do { u32x4 w = {cvtpk(Pv[BASE + 0], Pv[BASE + 1]), cvtpk(Pv[BASE + 2], Pv[BASE + 3]), cvtpk(Pv[BASE + 4], Pv[BASE + 5]), cvtpk(Pv[BASE + 6], Pv[BASE + 7])}; \
    OUT = *reinterpret_cast<bf16x8*>(&w); } while (0)
  PK4(p0, 0, pa0); PK4(p0, 8, pa1); PK4(p1, 0, pa2); PK4(p1, 8, pa3);
#undef PK4
}

template <int DQK, int DV, bool SWA, bool FAST>
__device__ __forceinline__ bool attn_core(f32x16 (&o)[DV / 32], const bf16x8 (&qr)[DQK / 16],
    const bf16_t* __restrict__ Kp, int ldk, const bf16_t* __restrict__ Kp2, int ldk2, const bf16_t* __restrict__ Vp, int ldv,
    int NT, int NL, int lo, int qpos, float sink_l2, char* lds) {
  constexpr int NCB = DV / 32, KSTR = DQK * 2 + 16, SHM_K = 64 * KSTR, SHM_V = 64 * DV * 2;
  constexpr int NKC = DQK == 64 ? 1 : 2, NVC = DV / 64;
  constexpr float SCALE = ScaleOf<DQK>::v, C = SCALE * LOG2E;
  int tid = threadIdx.x; LAUNDER_V(tid);
  const int wid = tid >> 6, lane = tid & 63, r32 = lane & 31, hi = lane >> 5;
  const bool grp1 = (wid & 4) != 0;
  char* V_lds = lds; char* K_lds = lds + 4 * SHM_V;
  float* wsf = (float*)(lds + 4 * SHM_V + 4 * SHM_K) + wid * 64; float* li_l = wsf; float* al_l = wsf + 32;
  float m_reg = -1e30f, l_reg = 0.f, alpha = 1.f;
#pragma unroll
  for (int d = 0; d < NCB; ++d) o[d] = f32x16{};
  unsigned ko[NKC]; int kl[NKC]; unsigned vo[NVC]; int vl[NVC];
  if constexpr (DQK == 128) {
#pragma unroll
    for (int i = 0; i < 2; ++i) { const int row = (tid >> 4) + 32 * i, c = tid & 15; ko[i] = (unsigned)(row * ldk + c * 8) * 2u; kl[i] = row * KSTR + c * 16; }
  } else if constexpr (DQK == 64) {
    const int row = tid >> 3, c = tid & 7; ko[0] = (unsigned)(row * ldk + c * 8) * 2u; kl[0] = row * KSTR + c * 16;
  } else {
    { const int row = tid >> 3, c = tid & 7; ko[0] = (unsigned)(row * ldk + c * 8) * 2u; kl[0] = row * KSTR + c * 16; }
    { const int t2 = tid & 255; const int row = t2 >> 2, c = t2 & 3; ko[1] = (unsigned)(row * ldk2 + c * 8) * 2u; kl[1] = row * KSTR + (8 + c) * 16; }
  }
  if constexpr (DV == 128) {
#pragma unroll
    for (int i = 0; i < 2; ++i) { const int row = (tid >> 4) + 32 * i, c = (tid & 15) * 8; vo[i] = (unsigned)(row * ldv + c) * 2u; vl[i] = v_st<NCB>(row, c); }
  } else {
    const int row = tid >> 3, c = (tid & 7) * 8; vo[0] = (unsigned)(row * ldv + c) * 2u; vl[0] = v_st<NCB>(row, c);
  }
  const int vb0 = (int)(uintptr_t)V_lds + v_rd_base(lane);
  const int ka0 = (int)(uintptr_t)K_lds + r32 * KSTR + hi * 16;
  bf16x8 sk[2][NKC], sv[2][NVC];
#define TROW(j) ((j) < NL ? lo + 64 * (j) : SEQ + 64 * ((j) - NL))
#define SLOAD(s, j) do { const size_t ro_ = (size_t)TROW(j); const char* kb_ = (const char*)Kp + ro_ * ldk * 2; const char* vb_ = (const char*)Vp + ro_ * ldv * 2; \
    sk[s][0] = *(const bf16x8*)(kb_ + ko[0]); \
    if constexpr (DQK == 128) sk[s][NKC - 1] = *(const bf16x8*)(kb_ + ko[NKC - 1]); \
    if constexpr (DQK == 96) sk[s][NKC - 1] = *(const bf16x8*)((const char*)Kp2 + ro_ * ldk2 * 2 + ko[NKC - 1]); \
    _Pragma("unroll") for (int i_ = 0; i_ < NVC; ++i_) sv[s][i_] = *(const bf16x8*)(vb_ + vo[i_]); } while (0)
#define SWRITE(slot, s) do { _Pragma("unroll") for (int i_ = 0; i_ < NVC; ++i_) *(bf16x8*)(V_lds + (slot) * SHM_V + vl[i_]) = sv[s][i_]; \
    _Pragma("unroll") for (int i_ = 0; i_ < NKC; ++i_) *(bf16x8*)(K_lds + (slot) * SHM_K + kl[i_]) = sk[s][i_]; } while (0)
#define RESC(a) do { if (__any((a) < 1.f)) { if (hi == 0) al_l[r32] = (a); asm volatile("s_waitcnt lgkmcnt(0)" ::: "memory"); \
    _Pragma("unroll") for (int d = 0; d < NCB; ++d) _Pragma("unroll") for (int r = 0; r < 16; ++r) o[d][r] *= al_l[crow(r, hi)]; } } while (0)
#define MASK(pa_, pb_, j) do { if constexpr (SWA) { if ((j) < NL) swa_mask(pa_, pb_, lo + 64 * (j), qpos, hi); } } while (0)
#define VSEG(t) do { SBAR(); softmax_tile<DQK, FAST>(pn0, pn1, m_reg, l_reg, alpha, pa0, pa1, pa2, pa3); if constexpr (!FAST) RESC(alpha); \
    if ((t) + 1 < NT) { qkt<DQK>(pn0, pn1, K_lds + (((t) + 1) & 3) * SHM_K, qr, r32, hi); MASK(pn0, pn1, (t) + 1); } \
    SBAR(); __syncthreads(); } while (0)
#define MSEG(t, STG) do { SBAR(); __builtin_amdgcn_s_setprio(2); \
    if ((t) + 3 < NT) { SWRITE(((t) + 3) & 3, STG); if ((t) + 5 < NT) SLOAD(STG, (t) + 5); } \
    const int vbt_ = vb0 + ((t) & 3) * SHM_V; \
    if constexpr (DV == 64) mseg_body<DQK, DV, false>(pn0, pn1, o, qr, ka0, vbt_, pa0, pa1, pa2, pa3); \
    else pv_all<NCB>(o, vbt_, pa0, pa1, pa2, pa3); \
    __builtin_amdgcn_s_setprio(0); SBAR(); __syncthreads(); } while (0)
  f32x16 pn0, pn1; bf16x8 pa0, pa1, pa2, pa3;
  SLOAD(0, 0); SLOAD(1, 1);
  SWRITE(0, 0); if (2 < NT) SLOAD(0, 2);
  SWRITE(1, 1); if (3 < NT) SLOAD(1, 3);
  __syncthreads();
  if (grp1) __syncthreads();
  if (2 < NT) { SWRITE(2, 0); if (4 < NT) SLOAD(0, 4); }
  qkt<DQK>(pn0, pn1, K_lds, qr, r32, hi); MASK(pn0, pn1, 0);
  __syncthreads();
  for (int t = 0; t < NT; t += 2) {
    VSEG(t); MSEG(t, 1);
    VSEG(t + 1); MSEG(t + 1, 0);
  }
  if (!grp1) __syncthreads();
  if constexpr (SWA) l_reg += FAST ? __builtin_amdgcn_exp2f(sink_l2) : __builtin_amdgcn_exp2f(sink_l2 - m_reg * C);
  const bool bad = __any(!(l_reg > 1.0e-20f && l_reg < 1.0e30f));
  if (hi == 0) li_l[r32] = l_reg; asm volatile("s_waitcnt lgkmcnt(0)" ::: "memory");
#pragma unroll
  for (int r = 0; r < 16; ++r) { const float rl = __builtin_amdgcn_rcpf(li_l[crow(r, hi)]);
#pragma unroll
    for (int d = 0; d < NCB; ++d) o[d][r] *= rl; }
  __syncthreads();
  return bad;
#undef TROW
#undef SLOAD
#undef SWRITE
#undef RESC
#undef MASK
#undef VSEG
#undef MSEG
}

__device__ __forceinline__ void scale8(bf16x8& v, float c) { float f[8]; unpack8(v, f);
#pragma unroll
  for (int e = 0; e < 8; ++e) f[e] *= c;
  v = pack8(f); }
__device__ __forceinline__ bool wg_any(bool flag, char* lds) {
  volatile int* w = (volatile int*)lds;
  if (threadIdx.x == 0) w[0] = 0;
  __syncthreads();
  if (flag && (threadIdx.x & 63) == 0) w[0] = 1;
  __syncthreads();
  const bool r = w[0] != 0;
  __syncthreads();
  return r;
}
#define ATTN_PASS(DQK_, DV_, SWA_, ...) do { constexpr float Cq_ = ScaleOf<DQK_>::v * LOG2E; \
    _Pragma("unroll") for (int d0 = 0; d0 < DQK_ / 16; ++d0) scale8(qr[d0], Cq_); \
    bool bad_ = attn_core<DQK_, DV_, SWA_, true>(__VA_ARGS__); \
    if (wg_any(bad_, lds)) { _Pragma("unroll") for (int d0 = 0; d0 < DQK_ / 16; ++d0) scale8(qr[d0], 1.f / Cq_); \
      attn_core<DQK_, DV_, SWA_, false>(__VA_ARGS__); } } while (0)

template <int KIND>
__device__ __forceinline__ void attn_item(const P& p, int b, int h, int qb, bool is_ctx, char* lds) {
  constexpr int DQK = KIND == 0 ? 96 : KIND == 2 ? 128 : 64;
  constexpr int DV = (KIND == 1 || KIND == 2) ? 128 : 64;
  constexpr int NCB = DV / 32;
  int tid = threadIdx.x; LAUNDER_V(tid);
  const int wid = tid >> 6, lane = tid & 63, r32 = lane & 31, hi = lane >> 5;
  const int rowb = b * TPB;
  const int q_t0 = is_ctx ? SEQ : qb * 256;
  const int qt = q_t0 + wid * 32 + r32;
  const size_t qrow = (size_t)rowb + qt;
  const int krow0 = is_ctx ? rowb + SEQ : rowb;
  int NT, NL, lo;
  if (is_ctx) { NT = 4; NL = 4; lo = 0; }
  else if (KIND == 3) { lo = q_t0 - 128 < 0 ? 0 : q_t0 - 128; const int he = q_t0 + 384 > SEQ ? SEQ : q_t0 + 384; NL = (he - lo) / 64; NT = NL + 4; }
  else { NT = TPB / 64; NL = NT; lo = 0; }
  const float* rt = (const float*)(p.ws + WS_ROPE);
  const bf16_t* proj = (const bf16_t*)(p.ws + WS_PROJ);
  bf16_t* ob = (bf16_t*)(p.ws + WS_ABUF);
  const int prow = qt >> 6, pcol = qt & 63;
  f32x16 o[NCB];

  if constexpr (KIND == 1) {
    const float lam = ((const float*)(p.ws + WS_MISC))[0];
#pragma unroll 1
    for (int map = 0; map < 2; ++map) {
      const int m = 2 * h + map;
      bf16x8 qr[4];
      { const bf16_t* qp = proj + qrow * NPAD1 + m * 64 + hi * 8;
#pragma unroll
        for (int d0 = 0; d0 < 4; ++d0) qr[d0] = *(const bf16x8*)(qp + d0 * 16); }
      if (!is_ctx) {
        const float* T = rt + ROPE64_OFF;
        rope8(qr[0], qr[2], T + prow * 16 + hi * 8, T + 256 * 16 + prow * 16 + hi * 8);
        rope8(qr[1], qr[3], T + pcol * 16 + hi * 8, T + 256 * 16 + pcol * 16 + hi * 8);
      }
      ATTN_PASS(64, 128, false, o, qr, proj + (size_t)krow0 * NPAD1 + 1024 + m * 64, NPAD1, nullptr, 0,
                proj + (size_t)krow0 * NPAD1 + 2048 + h * 128, NPAD1, NT, NL, lo, qt, 0.f, lds);
      char* obw = (char*)(ob + ((size_t)rowb + q_t0) * 1024 + h * 128);
      const char* gbw = (const char*)(proj + ((size_t)rowb + q_t0) * NPAD1 + 3072 + h * 128);
      int te = threadIdx.x; LAUNDER_V(te);
      const int wid = te >> 6, r32 = te & 31, hi = (te >> 5) & 1;
      const unsigned oo = (unsigned)((wid * 32 + 4 * hi) * 1024 + r32) * 2u;
      const unsigned go = (unsigned)((wid * 32 + 4 * hi) * NPAD1 + r32) * 2u;
      if (map == 0) {
#pragma unroll
        for (int r = 0; r < 16; ++r) {
          const unsigned ro = oo + (unsigned)(((r & 3) + 8 * (r >> 2)) * 2048);
#pragma unroll
          for (int d = 0; d < 4; ++d) *(bf16_t*)(obw + ro + d * 64) = f2bf(o[d][r]);
          if ((r & 3) == 3) SBAR();
        }
      } else {
        float gs[4];
#pragma unroll
        for (int d = 0; d < 4; ++d) gs[d] = p.diff_g_sub[d * 32 + r32] * (1.f - LAMBDA_INIT);
#pragma unroll
        for (int r = 0; r < 16; ++r) {
          const unsigned ro = oo + (unsigned)(((r & 3) + 8 * (r >> 2)) * 2048);
          const unsigned rg = go + (unsigned)(((r & 3) + 8 * (r >> 2)) * (NPAD1 * 2));
          float dv[4]; float ss = 0.f;
#pragma unroll
          for (int d = 0; d < 4; ++d) { const float o1 = bf2f((short)*(const bf16_t*)(obw + ro + d * 64)); dv[d] = o1 - lam * o[d][r]; ss += dv[d] * dv[d]; }
          ss += __shfl_xor(ss, 1); ss += __shfl_xor(ss, 2); ss += __shfl_xor(ss, 4); ss += __shfl_xor(ss, 8); ss += __shfl_xor(ss, 16);
          const float rstd = rsqrtf(ss * (1.f / 128.f) + EPS);
#pragma unroll
          for (int d = 0; d < 4; ++d) {
            const float g = bf2f((short)*(const bf16_t*)(gbw + rg + d * 64));
            *(bf16_t*)(obw + ro + d * 64) = f2bf(dv[d] * rstd * gs[d] * silu_f(g));
          }
          if ((r & 1) == 1) SBAR();
        }
      }
    }
  } else {
    bf16x8 qr[DQK / 16];
    const bf16_t *Kp, *Kp2 = nullptr, *Vp, *gbase; int ldk, ldk2 = 0, ldv, ldg; float sink_l2 = 0.f;
    if constexpr (KIND == 0) {
      const bf16_t* q2 = (const bf16_t*)(p.ws + WS_X); const bf16_t* kv2 = (const bf16_t*)(p.ws + WS_KV2);
      const bf16_t* qp = q2 + qrow * 1536 + h * 96 + hi * 8;
#pragma unroll
      for (int d0 = 0; d0 < 6; ++d0) qr[d0] = *(const bf16x8*)(qp + d0 * 16);
      if (!is_ctx) { const int pos = hi ? pcol : prow; const float* T = rt + ROPE32_OFF; rope8(qr[4], qr[5], T + pos * 8, T + 256 * 8 + pos * 8); }
      Kp = kv2 + (size_t)krow0 * 2048 + h * 128; ldk = 2048; Kp2 = proj + (size_t)krow0 * NPAD0 + 384; ldk2 = NPAD0;
      Vp = kv2 + (size_t)krow0 * 2048 + h * 128 + 64; ldv = 2048;
      gbase = proj + ((size_t)rowb + q_t0) * NPAD0 + 416 + h * 64; ldg = NPAD0;
    } else if constexpr (KIND == 2) {
      const bf16_t* qp = proj + qrow * NPAD2 + h * 128 + hi * 8;
      float ss = 0.f; float xf[8][8];
#pragma unroll
      for (int d0 = 0; d0 < 8; ++d0) { unpack8(*(const bf16x8*)(qp + d0 * 16), xf[d0]);
#pragma unroll
        for (int e = 0; e < 8; ++e) ss += xf[d0][e] * xf[d0][e]; }
      ss += __shfl_xor(ss, 32);
      const float rstd = rsqrtf(ss * (1.f / 128.f) + EPS);
#pragma unroll
      for (int d0 = 0; d0 < 8; ++d0) {
        const f32x4 g0 = *(const f32x4*)(p.gqa_g_q + d0 * 16 + hi * 8), g1 = *(const f32x4*)(p.gqa_g_q + d0 * 16 + hi * 8 + 4);
#pragma unroll
        for (int e = 0; e < 8; ++e) xf[d0][e] *= rstd * (e < 4 ? g0[e & 3] : g1[e & 3]);
      }
      if (!is_ctx) {
        const float* T = rt + ROPE128_OFF;
#pragma unroll
        for (int d0 = 0; d0 < 4; ++d0) { const int pos = d0 < 2 ? prow : pcol; const int f0 = (d0 & 1) * 16 + hi * 8;
          rope8f(xf[d0], xf[d0 + 4], T + pos * 32 + f0, T + 256 * 32 + pos * 32 + f0); }
      }
#pragma unroll
      for (int d0 = 0; d0 < 8; ++d0) qr[d0] = pack8(xf[d0]);
      const int kvh = h >> 2;
      Kp = proj + (size_t)krow0 * NPAD2 + 1024 + kvh * 128; ldk = NPAD2; Vp = proj + (size_t)krow0 * NPAD2 + 1280 + kvh * 128; ldv = NPAD2;
      gbase = proj + ((size_t)rowb + q_t0) * NPAD2 + 1536 + h * 128; ldg = NPAD2;
    } else {
      const bf16_t* qp = proj + qrow * NPAD3 + h * 64 + hi * 8;
#pragma unroll
      for (int d0 = 0; d0 < 4; ++d0) qr[d0] = *(const bf16x8*)(qp + d0 * 16);
      if (!is_ctx) {
        const float* T = rt + ROPE64_OFF;
        rope8(qr[0], qr[2], T + prow * 16 + hi * 8, T + 256 * 16 + prow * 16 + hi * 8);
        rope8(qr[1], qr[3], T + pcol * 16 + hi * 8, T + 256 * 16 + pcol * 16 + hi * 8);
      }
      const int kvh = h >> 3;
      Kp = proj + (size_t)krow0 * NPAD3 + 1024 + kvh * 64; ldk = NPAD3; Vp = proj + (size_t)krow0 * NPAD3 + 1152 + kvh * 64; ldv = NPAD3;
      gbase = proj + ((size_t)rowb + q_t0) * NPAD3 + 1280 + h * 64; ldg = NPAD3;
      sink_l2 = p.swa_sink[h] * LOG2E;
    }
    ATTN_PASS(DQK, DV, KIND == 3, o, qr, Kp, ldk, Kp2, ldk2, Vp, ldv, NT, NL, lo, qt, sink_l2, lds);
    char* obw = (char*)(ob + ((size_t)rowb + q_t0) * 1024 + h * DV);
    const char* gbw = (const char*)gbase;
    int te = threadIdx.x; LAUNDER_V(te);
    const int wid2 = te >> 6, r32b = te & 31, hi2 = (te >> 5) & 1;
    const unsigned oo = (unsigned)((wid2 * 32 + 4 * hi2) * 1024 + r32b) * 2u;
    const unsigned go = (unsigned)((wid2 * 32 + 4 * hi2) * ldg + r32b) * 2u;
#pragma unroll
    for (int r = 0; r < 16; ++r) {
      const unsigned ro = oo + (unsigned)(((r & 3) + 8 * (r >> 2)) * 2048);
      const unsigned rg = go + (unsigned)(((r & 3) + 8 * (r >> 2)) * ldg * 2);
#pragma unroll
      for (int d = 0; d < NCB; ++d) {
        const float g = bf2f((short)*(const bf16_t*)(gbw + rg + d * 64));
        *(bf16_t*)(obw + ro + d * 64) = f2bf(o[d][r] * silu_f(g));
      }
      if ((r & 3) == 3) SBAR();
    }
  }
}

template <int KIND>
__device__ __forceinline__ void phase_attn(const P& p, char* lds) {
  constexpr int H = (KIND == 0 || KIND == 3) ? 16 : 8;
  constexpr int nlat = NBATCH * H * 64, nctx = KIND < 3 ? NBATCH * H : 0;
  for (int it = blockIdx.x; it < nlat + nctx; it += gridDim.x) {
    if (it < nlat) {
      int qb = it & 63, hh = it >> 6;
      if (gridDim.x == 256) {
        const int x = it & 7, j = (it & 255) >> 3; hh = (it >> 8) * 4 + (x >> 1); qb = j + 32 * (x & 1);
      }
      attn_item<KIND>(p, hh / H, hh % H, qb, false, lds);
    }
    else { const int j = it - nlat; attn_item<KIND>(p, j / H, j % H, 0, true, lds); }
  }
}

__device__ __forceinline__ P load_params() {
#if defined(__HIP_DEVICE_COMPILE__)
  auto pp = (const __attribute__((address_space(4))) P*)__builtin_amdgcn_kernarg_segment_ptr();
  asm volatile("" : "+s"(pp));
  return *pp;
#else
  return P{};
#endif
}
__global__ __launch_bounds__(NTHR) void mega(P p_unused) {
  extern __shared__ __attribute__((aligned(16))) char lds[];
  cg::grid_group grid = cg::this_grid();
  phase_prep(load_params(), lds); grid.sync();
#define GSYNC(k) grid_barrier((unsigned*)(load_params().ws + WS_BAR), (unsigned)(k))
  phase_h0(load_params()); GSYNC(1);
#pragma unroll 1
  for (int layer = 0; layer < 4; ++layer) {
    const int e0 = 2 + 5 * layer;
    phase_gemm1(load_params(), layer, lds); GSYNC(e0);
    if (layer == 0) { phase_kfix<0>(load_params()); phase_gemm2(load_params(), lds); }
    else if (layer == 1) phase_kfix<1>(load_params());
    else if (layer == 2) phase_kfix<2>(load_params());
    else phase_kfix<3>(load_params());
    GSYNC(e0 + 1);
    if (layer == 0) phase_attn<0>(load_params(), lds);
    else if (layer == 1) phase_attn<1>(load_params(), lds);
    else if (layer == 2) phase_attn<2>(load_params(), lds);
    else phase_attn<3>(load_params(), lds);
    GSYNC(e0 + 2);
    phase_outproj(load_params(), layer, lds); GSYNC(e0 + 3);
    phase_ln(load_params(), layer);
    if (layer < 3) GSYNC(e0 + 4);
  }
}

extern "C" void kernel_launch(void* const* d_in, const int* in_sizes, int n_in, void* d_out, int out_size, void* d_ws, size_t ws_size, hipStream_t stream) {
  static int grid_blocks = 0;
  if (!grid_blocks) {
    if (ws_size < WS_END) { fprintf(stderr, "kernel_launch: workspace too small: %zu < %zu\n", ws_size, (size_t)WS_END); return; }
    if (hipFuncSetAttribute((const void*)mega, hipFuncAttributeMaxDynamicSharedMemorySize, LDS_BYTES) != hipSuccess) { fprintf(stderr, "kernel_launch: LDS attribute failed\n"); return; }
    int dev = 0, cus = 0, per_cu = 0;
    hipGetDevice(&dev);
    hipDeviceGetAttribute(&cus, hipDeviceAttributeMultiprocessorCount, dev);
    hipOccupancyMaxActiveBlocksPerMultiprocessor(&per_cu, mega, NTHR, LDS_BYTES);
    if (per_cu < 1) { fprintf(stderr, "kernel_launch: occupancy 0\n"); return; }
    grid_blocks = cus * 1;
  }
  P p{};
  p.x = (const float*)d_in[0]; p.c = (const float*)d_in[1]; p.ctx = (const float*)d_in[2]; p.c_ctx = (const float*)d_in[3];
  p.ada_w = (const float*)d_in[4]; p.ada_b = (const float*)d_in[5]; p.out_w = (const float*)d_in[6]; p.ln_g = (const float*)d_in[7]; p.ln_b = (const float*)d_in[8];
  p.mla_w_in = (const float*)d_in[9]; p.mla_g_qa = (const float*)d_in[10]; p.mla_w_qb = (const float*)d_in[11]; p.mla_g_kva = (const float*)d_in[12]; p.mla_w_kvb = (const float*)d_in[13];
  p.diff_w_in = (const float*)d_in[14]; p.diff_lambda = (const float*)d_in[15]; p.diff_g_sub = (const float*)d_in[16];
  p.gqa_w_in = (const float*)d_in[17]; p.gqa_g_q = (const float*)d_in[18]; p.gqa_g_k = (const float*)d_in[19];
  p.swa_w_in = (const float*)d_in[20]; p.swa_sink = (const float*)d_in[21];
  p.out = (float*)d_out; p.ws = (char*)d_ws;
  hipMemsetAsync((char*)d_ws + WS_BAR, 0, 256, stream);
  void* args[] = {&p};
  hipError_t e = hipLaunchCooperativeKernel((const void*)mega, dim3(grid_blocks), dim3(NTHR), args, LDS_BYTES, stream);
  if (e != hipSuccess) fprintf(stderr, "cooperative launch failed: %s (grid %d)\n", hipGetErrorString(e), grid_blocks);
}
```

```cpp
#include <hip/hip_runtime.h>
#include <hip/hip_cooperative_groups.h>
#include <cstdio>
#include <cstdint>
namespace cg = cooperative_groups;

typedef unsigned short bf16_t;
using bf16x8 = __attribute__((ext_vector_type(8))) short;
using s16x4  = __attribute__((ext_vector_type(4))) short;
using f32x16 = __attribute__((ext_vector_type(16))) float;
using f32x4  = __attribute__((ext_vector_type(4))) float;
using u32x4  = __attribute__((ext_vector_type(4))) unsigned;
using u32x2  = __attribute__((ext_vector_type(2))) unsigned;

constexpr int DM = 1024, NBATCH = 2, SEQ = 16384, CTXL = 256, TPB = SEQ + CTXL, NROW = NBATCH * TPB;
constexpr int NTHR = 512;
constexpr float EPS = 1e-6f;
constexpr float ALPHA = 1.681792830507429f;
constexpr float LAMBDA_INIT = 0.35550906759096544f;
constexpr float LOG2E = 1.4426950408889634f;

constexpr size_t al256(size_t x) { return (x + 255) / 256 * 256; }
constexpr int NPAD0 = 1536, NPAD1 = 4096, NPAD2 = 2560, NPAD3 = 2304;
constexpr size_t WS_WIN0 = 0;
constexpr size_t WS_WIN1 = WS_WIN0 + (size_t)NPAD0 * 1024 * 2;
constexpr size_t WS_WIN2 = WS_WIN1 + (size_t)NPAD1 * 1024 * 2;
constexpr size_t WS_WIN3 = WS_WIN2 + (size_t)NPAD2 * 1024 * 2;
constexpr size_t WS_WOUT = WS_WIN3 + (size_t)NPAD3 * 1024 * 2;
constexpr size_t WS_WQB  = WS_WOUT + (size_t)4 * 1024 * 1024 * 2;
constexpr size_t WS_WKVB = WS_WQB + (size_t)1536 * 256 * 2;
constexpr size_t WS_MOD  = WS_WKVB + (size_t)2048 * 128 * 2;
constexpr size_t WS_ROPE = WS_MOD + (size_t)4 * 3 * 3072 * 4;
constexpr int ROPE32_OFF = 0, ROPE64_OFF = 256 * 8 * 2, ROPE128_OFF = ROPE64_OFF + 256 * 16 * 2, ROPE_TOTAL = ROPE128_OFF + 256 * 32 * 2;
constexpr size_t WS_MISC = WS_ROPE + (size_t)ROPE_TOTAL * 4;
constexpr size_t WS_BAR  = al256(WS_MISC + 256);
constexpr size_t WS_ABUF = al256(WS_BAR + 256);
constexpr size_t WS_X    = WS_ABUF + (size_t)NROW * 1024 * 2;
constexpr size_t WS_PROJ = WS_X + (size_t)NROW * 1024 * 4;
constexpr size_t WS_KV2  = WS_PROJ + (size_t)NROW * 1536 * 2;
constexpr size_t WS_END  = WS_PROJ + (size_t)NROW * 4096 * 2;

constexpr int LDS_BYTES = 143360;

struct P {
  const float *x, *c, *ctx, *c_ctx, *ada_w, *ada_b, *out_w, *ln_g, *ln_b;
  const float *mla_w_in, *mla_g_qa, *mla_w_qb, *mla_g_kva, *mla_w_kvb;
  const float *diff_w_in, *diff_lambda, *diff_g_sub;
  const float *gqa_w_in, *gqa_g_q, *gqa_g_k;
  const float *swa_w_in, *swa_sink;
  float* out; char* ws;
};

#define SBAR() __builtin_amdgcn_sched_barrier(0)
#define LAUNDER_V(x) asm volatile("" : "+v"(x))
__device__ __forceinline__ int crow(int r, int hi) { return (r & 3) + 8 * (r >> 2) + 4 * hi; }
__device__ __forceinline__ unsigned cvtpk(float lo, float hi) {
  unsigned r; asm volatile("v_cvt_pk_bf16_f32 %0, %1, %2" : "=v"(r) : "v"(lo), "v"(hi)); return r;
}
__device__ __forceinline__ float bf2f(short v) { return __uint_as_float(((unsigned)(unsigned short)v) << 16); }
__device__ __forceinline__ bf16_t f2bf(float f) { return (bf16_t)(cvtpk(f, f) & 0xffffu); }
__device__ __forceinline__ float silu_f(float v) { return v / (1.f + __expf(-v)); }

__device__ __forceinline__ void grid_barrier(unsigned* ctr, unsigned epoch) {
  asm volatile("s_waitcnt vmcnt(0) lgkmcnt(0)" ::: "memory");
  __syncthreads();
  if (threadIdx.x == 0) {
    __builtin_amdgcn_fence(__ATOMIC_RELEASE, "agent");
    asm volatile("s_waitcnt vmcnt(0)" ::: "memory");
    __hip_atomic_fetch_add(ctr, 1u, __ATOMIC_RELAXED, __HIP_MEMORY_SCOPE_AGENT);
    const unsigned target = epoch * gridDim.x;
    while (__hip_atomic_load(ctr, __ATOMIC_RELAXED, __HIP_MEMORY_SCOPE_AGENT) < target) __builtin_amdgcn_s_sleep(1);
    __builtin_amdgcn_fence(__ATOMIC_ACQUIRE, "agent");
    asm volatile("s_waitcnt vmcnt(0)" ::: "memory");
  }
  __syncthreads();
}

__device__ __forceinline__ void transpose_tile(const float* __restrict__ src, int K, int N, bf16_t* __restrict__ dst, const float* __restrict__ gain, int tk, int tn, float* tile) {
  int tid = threadIdx.x; LAUNDER_V(tid);
  {
    const int n = tid & 63, kb = tid >> 6;
#pragma unroll
    for (int i = 0; i < 8; ++i) {
      const int k = kb + 8 * i; const int gn = tn * 64 + n, gk = tk * 64 + k;
      float v = 0.f;
      if (gn < N) { v = src[(size_t)gk * N + gn]; if (gain) v *= gain[gk]; }
      tile[k * 65 + n] = v;
    }
  }
  __syncthreads();
  {
    const int kk = (tid & 31) * 2, nb = tid >> 5;
#pragma unroll
    for (int i = 0; i < 4; ++i) {
      const int nn = nb + 16 * i;
      const unsigned w = cvtpk(tile[kk * 65 + nn], tile[(kk + 1) * 65 + nn]);
      *(unsigned*)(dst + (size_t)(tn * 64 + nn) * K + tk * 64 + kk) = w;
    }
  }
  __syncthreads();
}

__device__ __forceinline__ void phase_prep(const P& p, char* lds) {
  int tid = threadIdx.x; LAUNDER_V(tid);
  float* tile = (float*)lds;
  constexpr int T0 = 16 * 24, T1 = 16 * 64, T2 = 16 * 40, T3 = 16 * 36, TO = 16 * 16, TQ = 4 * 24, TK = 2 * 32;
  constexpr int E0 = T0, E1 = E0 + T1, E2 = E1 + T2, E3 = E2 + T3, E4 = E3 + 4 * TO, E5 = E4 + TQ, E6 = E5 + TK;
  for (int t = blockIdx.x; t < E6; t += gridDim.x) {
    const float* src; int K, N, NP; bf16_t* dst; const float* gain = nullptr; int lt;
    if (t < E0)      { lt = t;      src = p.mla_w_in;  K = 1024; N = 1440; NP = NPAD0; dst = (bf16_t*)(p.ws + WS_WIN0); }
    else if (t < E1) { lt = t - E0; src = p.diff_w_in; K = 1024; N = 4096; NP = NPAD1; dst = (bf16_t*)(p.ws + WS_WIN1); }
    else if (t < E2) { lt = t - E1; src = p.gqa_w_in;  K = 1024; N = 2560; NP = NPAD2; dst = (bf16_t*)(p.ws + WS_WIN2); }
    else if (t < E3) { lt = t - E2; src = p.swa_w_in;  K = 1024; N = 2304; NP = NPAD3; dst = (bf16_t*)(p.ws + WS_WIN3); }
    else if (t < E4) { lt = t - E3; const int l = lt / TO; lt -= l * TO; src = p.out_w + (size_t)l * 1024 * 1024; K = 1024; N = 1024; NP = 1024; dst = (bf16_t*)(p.ws + WS_WOUT) + (size_t)l * 1024 * 1024; }
    else if (t < E5) { lt = t - E4; src = p.mla_w_qb;  K = 256; N = 1536; NP = 1536; dst = (bf16_t*)(p.ws + WS_WQB); gain = p.mla_g_qa; }
    else             { lt = t - E5; src = p.mla_w_kvb; K = 128; N = 2048; NP = 2048; dst = (bf16_t*)(p.ws + WS_WKVB); gain = p.mla_g_kva; }
    const int ntn = NP / 64; const int tk = lt / ntn, tn = lt % ntn;
    transpose_tile(src, K, N, dst, gain, tk, tn, tile);
  }
  {
    float* sv = (float*)lds;
    float* red = (float*)lds + 3072;
    for (int i = tid; i < 3072; i += NTHR) {
      const int v = i >> 10, k = i & 1023;
      const float cv = v == 0 ? p.c[k] : v == 1 ? p.c[1024 + k] : p.c_ctx[k];
      sv[i] = silu_f(cv);
    }
    __syncthreads();
    for (int it = blockIdx.x; it < 4 * 48; it += gridDim.x) {
      const int l = it / 48, n0 = (it % 48) * 64;
      const int n = tid & 63, kc = tid >> 6;
      const float* w = p.ada_w + (size_t)l * 1024 * 3072 + (size_t)(kc * 128) * 3072 + n0 + n;
      float a0 = 0.f, a1 = 0.f, a2 = 0.f;
#pragma unroll 8
      for (int k = 0; k < 128; ++k) {
        const float wv = w[(size_t)k * 3072];
        a0 += sv[kc * 128 + k] * wv; a1 += sv[1024 + kc * 128 + k] * wv; a2 += sv[2048 + kc * 128 + k] * wv;
      }
      red[(kc * 64 + n) * 3 + 0] = a0; red[(kc * 64 + n) * 3 + 1] = a1; red[(kc * 64 + n) * 3 + 2] = a2;
      __syncthreads();
      if (tid < 192) {
        const int v = tid >> 6, nn = tid & 63; float s = 0.f;
#pragma unroll
        for (int q = 0; q < 8; ++q) s += red[(q * 64 + nn) * 3 + v];
        s += p.ada_b[l * 3072 + n0 + nn];
        ((float*)(p.ws + WS_MOD))[(l * 3 + v) * 3072 + n0 + nn] = s;
      }
      __syncthreads();
    }
  }
  {
    float* rt = (float*)(p.ws + WS_ROPE);
    const int gt = blockIdx.x * NTHR + tid;
    for (int i = gt; i < 256 * 56; i += gridDim.x * NTHR) {
      const int pos = i / 56, j = i % 56;
      int nf, f, off;
      if (j < 8) { nf = 8; f = j; off = ROPE32_OFF; } else if (j < 24) { nf = 16; f = j - 8; off = ROPE64_OFF; } else { nf = 32; f = j - 24; off = ROPE128_OFF; }
      const float inv = exp2f(-(float)f / (float)nf * 13.287712379549449f);
      const float ang = (float)pos * inv;
      const float kq = rintf(ang * 0.15915494309189535f);
      float r = fmaf(-kq, 6.28318548202514648f, ang); r = fmaf(-kq, -1.7484555e-07f, r);
      rt[off + pos * nf + f] = cosf(r); rt[off + 256 * nf + pos * nf + f] = sinf(r);
    }
    if (blockIdx.x == 0 && tid < 64) {
      const float* lm = p.diff_lambda;
      float s1 = lm[tid] * lm[64 + tid], s2 = lm[128 + tid] * lm[192 + tid];
#pragma unroll
      for (int o = 32; o >= 1; o >>= 1) { s1 += __shfl_xor(s1, o); s2 += __shfl_xor(s2, o); }
      if (tid == 0) ((float*)(p.ws + WS_MISC))[0] = __expf(s1) - __expf(s2) + LAMBDA_INIT;
    }
  }
}

__device__ __forceinline__ void phase_h0(const P& p) {
  const float* mod = (const float*)(p.ws + WS_MOD);
  bf16_t* hb = (bf16_t*)(p.ws + WS_ABUF);
  const size_t total = (size_t)NROW * 128;
  int tid = threadIdx.x; LAUNDER_V(tid);
  for (size_t i = (size_t)blockIdx.x * NTHR + tid; i < total; i += (size_t)gridDim.x * NTHR) {
    const int row = (int)(i >> 7), c8 = (int)(i & 127) * 8;
    const int b = row / TPB, t = row % TPB;
    const float* src; int v;
    if (t < SEQ) { src = p.x + ((size_t)b * SEQ + t) * 1024; v = b; } else { src = p.ctx + ((size_t)b * CTXL + (t - SEQ)) * 1024; v = 2; }
    const float* sh = mod + v * 3072 + c8; const float* sc = sh + 1024;
    const f32x4 x0 = *(const f32x4*)(src + c8), x1 = *(const f32x4*)(src + c8 + 4);
    const f32x4 s0 = *(const f32x4*)sc, s1 = *(const f32x4*)(sc + 4), h0 = *(const f32x4*)sh, h1 = *(const f32x4*)(sh + 4);
    u32x4 w;
    w.x = cvtpk(x0[0] * (1.f + s0[0]) + h0[0], x0[1] * (1.f + s0[1]) + h0[1]);
    w.y = cvtpk(x0[2] * (1.f + s0[2]) + h0[2], x0[3] * (1.f + s0[3]) + h0[3]);
    w.z = cvtpk(x1[0] * (1.f + s1[0]) + h1[0], x1[1] * (1.f + s1[1]) + h1[1]);
    w.w = cvtpk(x1[2] * (1.f + s1[2]) + h1[2], x1[3] * (1.f + s1[3]) + h1[3]);
    *(u32x4*)(hb + (size_t)row * 1024 + c8) = w;
  }
}

template <int MB, class Epi>
__device__ __forceinline__ void gemm_tile(const bf16_t* __restrict__ A, int lda, const bf16_t* __restrict__ Bt, int ldb, int K, const Epi& epi, char* lds) {
  int tid = threadIdx.x; LAUNDER_V(tid);
  const int wid = tid >> 6, lane = tid & 63, r32 = lane & 31, hi = lane >> 5;
  const int m0 = (wid >> 2) * (MB * 32), n0 = (wid & 3) * 64;
  const int sc = tid & 7, sr = tid >> 3;
  const unsigned aofs = (unsigned)(sr * lda + sc * 8) * 2u, bofs = (unsigned)(sr * ldb + sc * 8) * 2u;
  const int sw = sr * 128 + ((sc ^ ((sr >> 1) & 7)) << 4);
  const int xr = (r32 >> 1) & 7;
  const int aoff = (m0 + r32) * 128, boff = 32768 + (n0 + r32) * 128;
  const int co0 = ((0 + hi) ^ xr) << 4, co1 = ((2 + hi) ^ xr) << 4, co2 = ((4 + hi) ^ xr) << 4, co3 = ((6 + hi) ^ xr) << 4;
  f32x16 acc[MB][2];
#pragma unroll
  for (int i = 0; i < MB; ++i) { acc[i][0] = f32x16{}; acc[i][1] = f32x16{}; }
  u32x4 ra[MB], rb[4];
  const int nk = K >> 6;
#define GLOAD(kt) do { const char* ab_ = (const char*)A + (size_t)(kt) * 128; const char* bb_ = (const char*)Bt + (size_t)(kt) * 128; \
    _Pragma("unroll") for (int i = 0; i < MB; ++i) ra[i] = *(const u32x4*)(ab_ + (size_t)(i * 64) * lda * 2 + aofs); \
    _Pragma("unroll") for (int i = 0; i < 4; ++i) rb[i] = *(const u32x4*)(bb_ + (size_t)(i * 64) * ldb * 2 + bofs); } while (0)
#define GWRITE(buf) do { _Pragma("unroll") for (int i = 0; i < MB; ++i) *(u32x4*)(lds + (buf) * 65536 + sw + i * 8192) = ra[i]; \
    _Pragma("unroll") for (int i = 0; i < 4; ++i) *(u32x4*)(lds + (buf) * 65536 + 32768 + sw + i * 8192) = rb[i]; } while (0)
#define FLOAD(fa, fb, co) do { _Pragma("unroll") for (int mb = 0; mb < MB; ++mb) fa[mb] = *(const bf16x8*)(base + aoff + mb * 4096 + (co)); \
    _Pragma("unroll") for (int nb = 0; nb < 2; ++nb) fb[nb] = *(const bf16x8*)(base + boff + nb * 4096 + (co)); } while (0)
#define FMMA(fa, fb) do { _Pragma("unroll") for (int mb = 0; mb < MB; ++mb) _Pragma("unroll") for (int nb = 0; nb < 2; ++nb) \
    acc[mb][nb] = __builtin_amdgcn_mfma_f32_32x32x16_bf16(fa[mb], fb[nb], acc[mb][nb], 0, 0, 0); } while (0)
  GLOAD(0); GWRITE(0); if (nk > 1) GLOAD(1); __syncthreads();
  for (int kt = 0; kt < nk; ++kt) {
    const int buf = kt & 1;
    const char* base = lds + buf * 65536;
    bf16x8 a0[MB], b0[2], a1[MB], b1[2];
    FLOAD(a0, b0, co0); SBAR();
    if (kt + 1 < nk) { GWRITE(buf ^ 1); if (kt + 2 < nk) GLOAD(kt + 2); } SBAR();
    FLOAD(a1, b1, co1); FMMA(a0, b0); SBAR();
    FLOAD(a0, b0, co2); FMMA(a1, b1); SBAR();
    FLOAD(a1, b1, co3); FMMA(a0, b0); SBAR();
    FMMA(a1, b1); SBAR();
    __syncthreads();
  }
#undef GLOAD
#undef GWRITE
#undef FLOAD
#undef FMMA
  epi.template operator()<MB>(acc, m0, n0, r32, hi);
}

struct EpiBf16 {
  bf16_t* O; int ldo; const float* rs;
  template <int MB> __device__ __forceinline__ void operator()(const f32x16 (&acc)[MB][2], int m0, int n0, int r32, int hi) const {
    unsigned base = (unsigned)((m0 + 4 * hi) * ldo + n0 + r32) * 2u; LAUNDER_V(base);
    int rbase = m0 + 4 * hi; LAUNDER_V(rbase);
    char* Ob = (char*)O;
#pragma unroll
    for (int mb = 0; mb < MB; ++mb)
#pragma unroll
      for (int r = 0; r < 16; ++r) {
        const int rr = mb * 32 + (r & 3) + 8 * (r >> 2);
        const float s = rs ? rs[rbase + rr] : 1.f;
        const unsigned off = base + (unsigned)(rr * ldo) * 2u;
        *(bf16_t*)(Ob + off) = f2bf(acc[mb][0][r] * s);
        *(bf16_t*)(Ob + off + 64) = f2bf(acc[mb][1][r] * s);
        if ((r & 7) == 7) SBAR();
      }
  }
};
struct EpiOut {
  const float* res; float* out; const float* g;
  template <int MB> __device__ __forceinline__ void operator()(const f32x16 (&acc)[MB][2], int m0, int n0, int r32, int hi) const {
    const float g0 = g[n0 + r32], g1 = g[n0 + 32 + r32];
    unsigned base = (unsigned)((m0 + 4 * hi) * 1024 + n0 + r32) * 4u; LAUNDER_V(base);
    const char* rb = (const char*)res; char* ob = (char*)out;
#pragma unroll
    for (int mb = 0; mb < MB; ++mb)
#pragma unroll
      for (int r = 0; r < 16; ++r) {
        const unsigned off = base + (unsigned)((mb * 32 + (r & 3) + 8 * (r >> 2)) * 4096);
        const float x0 = *(const float*)(rb + off), x1 = *(const float*)(rb + off + 128);
        *(float*)(ob + off) = ALPHA * x0 + g0 * acc[mb][0][r];
        *(float*)(ob + off + 128) = ALPHA * x1 + g1 * acc[mb][1][r];
        if ((r & 3) == 3) SBAR();
      }
  }
};

namespace g8 {
constexpr int BK = 64, HALF = 128, HT = HALF * BK;
__device__ __forceinline__ int lds_byte(int r, int c) { const int st = (r >> 4) * 2 + (c >> 5), rr = r & 15, cc = c & 31, ob = rr * 64 + cc * 2; return st * 1024 + (ob ^ (((ob >> 9) & 1) << 5)); }
__device__ __forceinline__ void stage_rc(int b, int& R, int& C) { const int st = b / 1024, sb = b % 1024, swz = sb ^ (((sb >> 9) & 1) << 5); R = (st >> 1) * 16 + swz / 64; C = (st & 1) * 32 + (swz % 64) / 2; }
template <class Epi>
__device__ __forceinline__ void gemm_tile8(const bf16_t* __restrict__ A, const bf16_t* __restrict__ Bt, int K, const Epi& epi, char* lds) {
  bf16_t* shm = (bf16_t*)lds;
  int tid = threadIdx.x; LAUNDER_V(tid);
#define SA(b, h) (shm + ((b) * 2 + (h)) * HT)
#define SB(b, h) (shm + (4 + (b) * 2 + (h)) * HT)
#define STAGE(Pp, BASE, br, kt) do { const long g_ = (long)(br) * K + (long)(kt) * BK; \
    _Pragma("unroll") for (int i_ = 0; i_ < 2; ++i_) { const int b_ = tid * 16 + i_ * 8192; int r_, c_; stage_rc(b_, r_, c_); \
      __builtin_amdgcn_global_load_lds((const unsigned*)(BASE + g_ + (long)r_ * K + c_), (unsigned*)((char*)(Pp) + b_), 16, 0, 0); } } while (0)
#define LDA(dst, b, h) _Pragma("unroll") for (int m = 0; m < 4; ++m) _Pragma("unroll") for (int k = 0; k < 2; ++k) \
    dst[m][k] = *reinterpret_cast<const bf16x8*>((char*)SA(b, h) + lds_byte(wr * 64 + m * 16 + fr, k * 32 + fq * 8))
#define LDB(dst, b, h) _Pragma("unroll") for (int n = 0; n < 2; ++n) _Pragma("unroll") for (int k = 0; k < 2; ++k) \
    dst[n][k] = *reinterpret_cast<const bf16x8*>((char*)SB(b, h) + lds_byte(wc * 32 + n * 16 + fr, k * 32 + fq * 8))
#define MMA(ai, bj, Af, Bf) do { __builtin_amdgcn_s_setprio(1); \
    _Pragma("unroll") for (int m = 0; m < 4; ++m) _Pragma("unroll") for (int n = 0; n < 2; ++n) _Pragma("unroll") for (int k = 0; k < 2; ++k) \
      acc[ai][bj][m][n] = __builtin_amdgcn_mfma_f32_16x16x32_bf16(Bf[n][k], Af[m][k], acc[ai][bj][m][n], 0, 0, 0); \
    __builtin_amdgcn_s_setprio(0); } while (0)
#define WAIT_V(n) asm volatile("s_waitcnt vmcnt(" #n ")" ::: "memory")
#define WAIT_L(n) asm volatile("s_waitcnt lgkmcnt(" #n ")" ::: "memory")
#define BAR __builtin_amdgcn_s_barrier()
#define SCHED __builtin_amdgcn_sched_barrier(0)
  const int wid = tid >> 6, lane = tid & 63, wr = wid >> 2, wc = wid & 3, fr = lane & 15, fq = lane >> 4;
  f32x4 acc[2][2][4][2];
#pragma unroll
  for (int a_ = 0; a_ < 2; ++a_)
#pragma unroll
    for (int b_ = 0; b_ < 2; ++b_)
#pragma unroll
      for (int m = 0; m < 4; ++m) { acc[a_][b_][m][0] = f32x4{0.f, 0.f, 0.f, 0.f}; acc[a_][b_][m][1] = f32x4{0.f, 0.f, 0.f, 0.f}; }
  bf16x8 At[4][2], B0[2][2], B1[2][2];
  const int nt = K / BK;
  WAIT_V(0); __syncthreads();
  STAGE(SB(0, 0), Bt, 0, 0); STAGE(SA(0, 0), A, 0, 0);
  STAGE(SB(0, 1), Bt, HALF, 0); STAGE(SA(0, 1), A, HALF, 0);
  if (wr == 1) BAR;
  WAIT_V(4); BAR;
  STAGE(SB(1, 0), Bt, 0, 1); STAGE(SA(1, 0), A, 0, 1); STAGE(SB(1, 1), Bt, HALF, 1);
  WAIT_V(6); BAR;
  for (int t = 0; t < nt - 2; t += 2) {
    LDB(B0, 0, 0); SCHED; LDA(At, 0, 0); STAGE(SA(1, 1), A, HALF, t + 1);
    WAIT_L(8); BAR; WAIT_L(0); MMA(0, 0, At, B0); BAR; SCHED;
    LDB(B1, 0, 1); STAGE(SB(0, 0), Bt, 0, t + 2);
    BAR; WAIT_L(0); MMA(0, 1, At, B1); BAR;
    LDA(At, 0, 1); STAGE(SA(0, 0), A, 0, t + 2);
    BAR; WAIT_L(0); MMA(1, 0, At, B0); BAR; SCHED;
    STAGE(SB(0, 1), Bt, HALF, t + 2);
    WAIT_V(6); BAR; MMA(1, 1, At, B1); BAR;
    LDB(B0, 1, 0); SCHED; LDA(At, 1, 0); STAGE(SA(0, 1), A, HALF, t + 2);
    WAIT_L(8); BAR; WAIT_L(0); MMA(0, 0, At, B0); BAR; SCHED;
    LDB(B1, 1, 1); STAGE(SB(1, 0), Bt, 0, t + 3);
    BAR; WAIT_L(0); MMA(0, 1, At, B1); BAR;
    LDA(At, 1, 1); STAGE(SA(1, 0), A, 0, t + 3);
    BAR; WAIT_L(0); MMA(1, 0, At, B0); BAR; SCHED;
    STAGE(SB(1, 1), Bt, HALF, t + 3);
    WAIT_V(6); BAR; MMA(1, 1, At, B1); BAR;
  }
  { LDB(B0, 0, 0); LDA(At, 0, 0); STAGE(SA(1, 1), A, HALF, nt - 1);
    BAR; WAIT_L(0); MMA(0, 0, At, B0); BAR;
    LDB(B1, 0, 1); BAR; WAIT_L(0); MMA(0, 1, At, B1); BAR;
    LDA(At, 0, 1); WAIT_V(4); BAR; WAIT_L(0); MMA(1, 0, At, B0); MMA(1, 1, At, B1); BAR; }
  { LDB(B0, 1, 0); LDA(At, 1, 0); WAIT_V(2); BAR; WAIT_L(0); MMA(0, 0, At, B0); BAR;
    LDB(B1, 1, 1); WAIT_V(0); BAR; WAIT_L(0); MMA(0, 1, At, B1); BAR;
    LDA(At, 1, 1); BAR; WAIT_L(0); MMA(1, 0, At, B0); MMA(1, 1, At, B1); BAR; }
  if (wr == 0) BAR;
#undef SA
#undef SB
#undef STAGE
#undef LDA
#undef LDB
#undef MMA
#undef WAIT_V
#undef WAIT_L
#undef BAR
#undef SCHED
  epi(acc, wr, wc, fr, fq);
}
struct EpiBf16 {
  bf16_t* O; int ldo;
  __device__ __forceinline__ void operator()(const f32x4 (&acc)[2][2][4][2], int wr, int wc, int fr, int fq) const {
    unsigned base = (unsigned)((wr * 64 + fr) * ldo + wc * 32 + fq * 4) * 2u; LAUNDER_V(base);
    char* Ob = (char*)O;
#pragma unroll
    for (int ai = 0; ai < 2; ++ai)
#pragma unroll
      for (int m = 0; m < 4; ++m) {
        const unsigned ro = base + (unsigned)((ai * 128 + m * 16) * ldo) * 2u;
#pragma unroll
        for (int bj = 0; bj < 2; ++bj)
#pragma unroll
          for (int n = 0; n < 2; ++n) {
            const f32x4 v = acc[ai][bj][m][n];
            u32x2 w; w.x = cvtpk(v[0], v[1]); w.y = cvtpk(v[2], v[3]);
            *(u32x2*)(Ob + ro + (bj * 128 + n * 16) * 2) = w;
          }
        SBAR();
      }
  }
};
struct EpiOut {
  const float* res; float* out; const float* g;
  __device__ __forceinline__ void operator()(const f32x4 (&acc)[2][2][4][2], int wr, int wc, int fr, int fq) const {
    unsigned base = (unsigned)((wr * 64 + fr) * 1024 + wc * 32 + fq * 4) * 4u; LAUNDER_V(base);
    const char* rb = (const char*)res; char* ob = (char*)out;
    f32x4 gv[2][2];
#pragma unroll
    for (int bj = 0; bj < 2; ++bj)
#pragma unroll
      for (int n = 0; n < 2; ++n) gv[bj][n] = *(const f32x4*)(g + bj * 128 + wc * 32 + n * 16 + fq * 4);
#pragma unroll
    for (int ai = 0; ai < 2; ++ai)
#pragma unroll
      for (int m = 0; m < 4; ++m) {
        const unsigned ro = base + (unsigned)((ai * 128 + m * 16) * 4096);
#pragma unroll
        for (int bj = 0; bj < 2; ++bj)
#pragma unroll
          for (int n = 0; n < 2; ++n) {
            const unsigned o_ = ro + (bj * 128 + n * 16) * 4;
            const f32x4 x = *(const f32x4*)(rb + o_);
            *(f32x4*)(ob + o_) = x * ALPHA + gv[bj][n] * acc[ai][bj][m][n];
          }
        SBAR();
      }
  }
};
}

__device__ __forceinline__ void tile_order(int L, int nM, int nN, int& pm, int& pn) {
  const int nwg = nM * nN, q = nwg >> 3, r = nwg & 7, xcd = L & 7, off = L >> 3;
  const int wgid = (xcd < r ? xcd * (q + 1) : r * (q + 1) + (xcd - r) * q) + off;
  const int nig = 8 * nN, gid = wgid / nig, fm = gid * 8, gsz = (nM - fm) < 8 ? (nM - fm) : 8;
  pm = fm + ((wgid % nig) % gsz); pn = (wgid % nig) / gsz;
}
__device__ __forceinline__ void phase_gemm1(const P& p, int layer, char* lds) {
  const int npad = layer == 0 ? NPAD0 : layer == 1 ? NPAD1 : layer == 2 ? NPAD2 : NPAD3;
  const size_t woff = layer == 0 ? WS_WIN0 : layer == 1 ? WS_WIN1 : layer == 2 ? WS_WIN2 : WS_WIN3;
  const bf16_t* A = (const bf16_t*)(p.ws + WS_ABUF);
  const bf16_t* W = (const bf16_t*)(p.ws + woff);
  bf16_t* O = (bf16_t*)(p.ws + WS_PROJ);
  const int nN = npad / 256, nt = 128 * nN;
  for (int t = blockIdx.x; t < nt; t += gridDim.x) {
    int pl, pn; tile_order(t, 128, nN, pl, pn); const int pm = pl + pl / 64;
    g8::EpiBf16 e{O + (size_t)pm * 256 * npad + pn * 256, npad};
    g8::gemm_tile8(A + (size_t)pm * 256 * 1024, W + (size_t)pn * 256 * 1024, 1024, e, lds);
  }
  for (int u = gridDim.x - 1 - blockIdx.x; u < 8 * nN; u += gridDim.x) {
    const int q = u / nN, pn = u % nN; const size_t row0 = (size_t)(q >> 2) * TPB + SEQ + (q & 3) * 64;
    EpiBf16 e{O + row0 * npad + pn * 256, npad, nullptr};
    gemm_tile<1>(A + row0 * 1024, 1024, W + (size_t)pn * 256 * 1024, 1024, 1024, e, lds);
  }
}

__device__ __forceinline__ void phase_gemm2(const P& p, char* lds) {
  const bf16_t* P1 = (const bf16_t*)(p.ws + WS_PROJ);
  float* rs = (float*)(lds + 131072);
  int tid = threadIdx.x; LAUNDER_V(tid);
  for (int t = blockIdx.x; t < 130 * 14; t += gridDim.x) {
    const int pm = t / 14, j = t % 14;
    const bool isq = j < 6; const int pn = isq ? j : j - 6;
    const int KK = isq ? 256 : 128, acol = isq ? 0 : 256;
    const bf16_t* A = P1 + (size_t)pm * 256 * 1536 + acol;
    {
      const int r = tid >> 1, half = tid & 1;
      const bf16_t* ap = A + (size_t)r * 1536 + half * (KK / 2);
      float ss = 0.f;
      for (int i = 0; i < KK / 16; ++i) { const bf16x8 v = *(const bf16x8*)(ap + i * 8);
#pragma unroll
        for (int e = 0; e < 8; ++e) { const float f = bf2f(v[e]); ss += f * f; } }
      ss += __shfl_xor(ss, 1);
      if (!half) rs[r] = rsqrtf(ss / (float)KK + EPS);
    }
    __syncthreads();
    if (isq) {
      EpiBf16 e{(bf16_t*)(p.ws + WS_X) + (size_t)pm * 256 * 1536 + pn * 256, 1536, rs};
      gemm_tile<4>(A, 1536, (const bf16_t*)(p.ws + WS_WQB) + (size_t)pn * 256 * 256, 256, 256, e, lds);
    } else {
      EpiBf16 e{(bf16_t*)(p.ws + WS_KV2) + (size_t)pm * 256 * 2048 + pn * 256, 2048, rs};
      gemm_tile<4>(A, 1536, (const bf16_t*)(p.ws + WS_WKVB) + (size_t)pn * 256 * 128, 128, 128, e, lds);
    }
    __syncthreads();
  }
}

__device__ __forceinline__ void phase_outproj(const P& p, int layer, char* lds) {
  const bf16_t* A = (const bf16_t*)(p.ws + WS_ABUF);
  const bf16_t* W = (const bf16_t*)(p.ws + WS_WOUT) + (size_t)layer * 1024 * 1024;
  float* X = (float*)(p.ws + WS_X);
  const float* mod = (const float*)(p.ws + WS_MOD) + layer * 3 * 3072;
  for (int t = blockIdx.x; t < 128 * 4; t += gridDim.x) {
    int pl, pn; tile_order(t, 128, 4, pl, pn); const int pm = pl + pl / 64; const int b = pm / 65, lt = pm % 65;
    const float* res = layer == 0 ? p.x + ((size_t)b * SEQ + lt * 256) * 1024 : X + (size_t)pm * 256 * 1024;
    g8::EpiOut e{res + pn * 256, X + (size_t)pm * 256 * 1024 + pn * 256, mod + b * 3072 + 2048 + pn * 256};
    g8::gemm_tile8(A + (size_t)pm * 256 * 1024, W + (size_t)pn * 256 * 1024, 1024, e, lds);
  }
  if (layer < 3) {
    for (int u = blockIdx.x; u < 32; u += gridDim.x) {
      const int q = u >> 2, pn = u & 3; const int b = q >> 2; const size_t row0 = (size_t)b * TPB + SEQ + (q & 3) * 64;
      const float* res = layer == 0 ? p.ctx + ((size_t)b * CTXL + (q & 3) * 64) * 1024 : X + row0 * 1024;
      EpiOut e{res + pn * 256, X + row0 * 1024 + pn * 256, mod + 2 * 3072 + 2048 + pn * 256};
      gemm_tile<1>(A + row0 * 1024, 1024, W + (size_t)pn * 256 * 1024, 1024, 1024, e, lds);
    }
  }
}

__device__ __forceinline__ void phase_ln(const P& p, int layer) {
  float* X = (float*)(p.ws + WS_X);
  bf16_t* hb = (bf16_t*)(p.ws + WS_ABUF);
  const float* g = p.ln_g + layer * 1024; const float* bb = p.ln_b + layer * 1024;
  const float* modn = (const float*)(p.ws + WS_MOD) + (layer + 1) * 3 * 3072;
  const bool last = layer == 3;
  int tid = threadIdx.x; LAUNDER_V(tid);
  const int wid = tid >> 6, lane = tid & 63;
  for (int row = blockIdx.x * 8 + wid; row < NROW; row += gridDim.x * 8) {
    const int b = row / TPB, t = row % TPB;
    if (last && t >= SEQ) continue;
    float* xr = X + (size_t)row * 1024;
    f32x4 v[4]; float s = 0.f;
#pragma unroll
    for (int j = 0; j < 4; ++j) { v[j] = *(const f32x4*)(xr + j * 256 + lane * 4); s += (v[j][0] + v[j][1]) + (v[j][2] + v[j][3]); }
#pragma unroll
    for (int o = 32; o >= 1; o >>= 1) s += __shfl_xor(s, o);
    const float mean = s * (1.f / 1024.f); float q = 0.f;
#pragma unroll
    for (int j = 0; j < 4; ++j) { v[j] = v[j] - mean; q += (v[j][0] * v[j][0] + v[j][1] * v[j][1]) + (v[j][2] * v[j][2] + v[j][3] * v[j][3]); }
#pragma unroll
    for (int o = 32; o >= 1; o >>= 1) q += __shfl_xor(q, o);
    const float rstd = rsqrtf(q * (1.f / 1024.f) + EPS);
    const int vsel = t < SEQ ? b : 2;
    float* dst = last ? p.out + ((size_t)b * SEQ + t) * 1024 : xr;
#pragma unroll
    for (int j = 0; j < 4; ++j) {
      const int col = j * 256 + lane * 4;
      const f32x4 gg = *(const f32x4*)(g + col), be = *(const f32x4*)(bb + col);
      f32x4 y = v[j] * rstd * gg + be;
      *(f32x4*)(dst + col) = y;
      if (!last) {
        const f32x4 sh = *(const f32x4*)(modn + vsel * 3072 + col), sc = *(const f32x4*)(modn + vsel * 3072 + 1024 + col);
        u32x2 w; w.x = cvtpk(y[0] * (1.f + sc[0]) + sh[0], y[1] * (1.f + sc[1]) + sh[1]); w.y = cvtpk(y[2] * (1.f + sc[2]) + sh[2], y[3] * (1.f + sc[3]) + sh[3]);
        *(u32x2*)(hb + (size_t)row * 1024 + col) = w;
      }
    }
  }
}

__device__ __forceinline__ void unpack8(bf16x8 v, float (&f)[8]) {
#pragma unroll
  for (int e = 0; e < 8; ++e) f[e] = bf2f(v[e]);
}
__device__ __forceinline__ bf16x8 pack8(const float (&f)[8]) {
  u32x4 w = {cvtpk(f[0], f[1]), cvtpk(f[2], f[3]), cvtpk(f[4], f[5]), cvtpk(f[6], f[7])}; return *reinterpret_cast<bf16x8*>(&w);
}
__device__ __forceinline__ void rope8f(float (&x1)[8], float (&x2)[8], const float* cs, const float* sn) {
  const f32x4 c0 = *(const f32x4*)cs, c1 = *(const f32x4*)(cs + 4), s0 = *(const f32x4*)sn, s1 = *(const f32x4*)(sn + 4);
#pragma unroll
  for (int e = 0; e < 8; ++e) {
    const float c = e < 4 ? c0[e & 3] : c1[e & 3], s = e < 4 ? s0[e & 3] : s1[e & 3];
    const float a = x1[e], b = x2[e];
    x1[e] = a * c - b * s; x2[e] = b * c + a * s;
  }
}
__device__ __forceinline__ void rope8(bf16x8& a, bf16x8& b, const float* cs, const float* sn) {
  float x1[8], x2[8]; unpack8(a, x1); unpack8(b, x2); rope8f(x1, x2, cs, sn); a = pack8(x1); b = pack8(x2);
}

template <int KIND>
__device__ __forceinline__ void phase_kfix(const P& p) {
  constexpr int HD = KIND == 0 ? 32 : KIND == 2 ? 128 : 64;
  constexpr int UPR = KIND == 0 ? 1 : KIND == 1 ? 16 : 2;
  constexpr int G = HD / 16, NF = HD / 4;
  constexpr int LD = KIND == 0 ? NPAD0 : KIND == 1 ? NPAD1 : KIND == 2 ? NPAD2 : NPAD3;
  constexpr int BASE = KIND == 0 ? 384 : 1024;
  constexpr int ROFF = KIND == 0 ? ROPE32_OFF : KIND == 2 ? ROPE128_OFF : ROPE64_OFF;
  bf16_t* proj = (bf16_t*)(p.ws + WS_PROJ);
  const float* rt = (const float*)(p.ws + WS_ROPE) + ROFF;
  const size_t total = (size_t)NROW * UPR * G;
  int tid = threadIdx.x; LAUNDER_V(tid);
  for (size_t i = (size_t)blockIdx.x * NTHR + tid; i < total; i += (size_t)gridDim.x * NTHR) {
    const int sub = (int)(i % G); const size_t u = i / G; const int head = (int)(u % UPR); const int row = (int)(u / UPR);
    const int t = row % TPB; const bool latent = t < SEQ;
    if (KIND != 2 && !latent) continue;
    bf16_t* ptr = proj + (size_t)row * LD + BASE + head * HD + sub * 8;
    float x1[8], x2[8];
    unpack8(*(const bf16x8*)ptr, x1); unpack8(*(const bf16x8*)(ptr + HD / 2), x2);
    if (KIND == 2) {
      float ss = 0.f;
#pragma unroll
      for (int e = 0; e < 8; ++e) ss += x1[e] * x1[e] + x2[e] * x2[e];
      ss += __shfl_xor(ss, 1); ss += __shfl_xor(ss, 2); ss += __shfl_xor(ss, 4);
      const float rstd = rsqrtf(ss * (1.f / 128.f) + EPS);
#pragma unroll
      for (int e = 0; e < 8; ++e) { x1[e] *= rstd * p.gqa_g_k[sub * 8 + e]; x2[e] *= rstd * p.gqa_g_k[64 + sub * 8 + e]; }
    }
    if (latent) {
      const bool isrow = sub * 8 < NF; const int f0 = isrow ? sub * 8 : sub * 8 - NF; const int pos = isrow ? (t >> 6) : (t & 63);
      rope8f(x1, x2, rt + pos * NF + f0, rt + 256 * NF + pos * NF + f0);
    }
    *(bf16x8*)ptr = pack8(x1); *(bf16x8*)(ptr + HD / 2) = pack8(x2);
  }
}

template <int NCB> __device__ __forceinline__ int v_st(int k, int c) { const int kk = k;     return ((kk >> 3) * NCB + (c >> 5)) * 512 + ((kk & 7) * 32 + (c & 31)) * 2; }
__device__ __forceinline__ int v_rd_base(int lane) { return ((lane & 3) << 3) | (((lane >> 2) & 3) << 6) | (((lane >> 4) & 1) << 5) | (((lane >> 5) & 1) << 8); }
template <int OFF> __device__ __forceinline__ s16x4 tr_read(int vb) {
  s16x4 r; asm volatile("ds_read_b64_tr_b16 %0, %1 offset:%2" : "=&v"(r) : "v"(vb), "i"(OFF) : "memory"); return r;
}
template <int NCB, int D0> __device__ __forceinline__ void pv_one(f32x16& od, int vb, bf16x8 pa0, bf16x8 pa1, bf16x8 pa2, bf16x8 pa3) {
#define VOFF(ks, half) (((2 * (ks) + (half)) * NCB + D0) * 512)
  const s16x4 l0 = tr_read<VOFF(0, 0)>(vb), h0 = tr_read<VOFF(0, 1)>(vb), l1 = tr_read<VOFF(1, 0)>(vb), h1 = tr_read<VOFF(1, 1)>(vb);
  const s16x4 l2 = tr_read<VOFF(2, 0)>(vb), h2 = tr_read<VOFF(2, 1)>(vb), l3 = tr_read<VOFF(3, 0)>(vb), h3 = tr_read<VOFF(3, 1)>(vb);
#undef VOFF
  asm volatile("s_waitcnt lgkmcnt(0)" ::: "memory"); SBAR();
#define PK(L, H) (bf16x8){L[0], L[1], L[2], L[3], H[0], H[1], H[2], H[3]}
  od = __builtin_amdgcn_mfma_f32_32x32x16_bf16(pa0, PK(l0, h0), od, 0, 0, 0);
  od = __builtin_amdgcn_mfma_f32_32x32x16_bf16(pa1, PK(l1, h1), od, 0, 0, 0);
  od = __builtin_amdgcn_mfma_f32_32x32x16_bf16(pa2, PK(l2, h2), od, 0, 0, 0);
  od = __builtin_amdgcn_mfma_f32_32x32x16_bf16(pa3, PK(l3, h3), od, 0, 0, 0);
#undef PK
}
template <int NCB, int KS> __device__ __forceinline__ void v_reads_ks(s16x4 (&v)[8], int vb) {
#define VOFF(d, half) (((2 * KS + (half)) * NCB + (d)) * 512)
  v[0] = tr_read<VOFF(0, 0)>(vb); v[1] = tr_read<VOFF(0, 1)>(vb); v[2] = tr_read<VOFF(1, 0)>(vb); v[3] = tr_read<VOFF(1, 1)>(vb);
  v[4] = tr_read<VOFF(2, 0)>(vb); v[5] = tr_read<VOFF(2, 1)>(vb); v[6] = tr_read<VOFF(3, 0)>(vb); v[7] = tr_read<VOFF(3, 1)>(vb);
#undef VOFF
}
__device__ __forceinline__ void pv_mm_ks(f32x16 (&o)[4], const s16x4 (&v)[8], bf16x8 pa) {
#define PK(L, H) (bf16x8){L[0], L[1], L[2], L[3], H[0], H[1], H[2], H[3]}
  o[0] = __builtin_amdgcn_mfma_f32_32x32x16_bf16(pa, PK(v[0], v[1]), o[0], 0, 0, 0);
  o[1] = __builtin_amdgcn_mfma_f32_32x32x16_bf16(pa, PK(v[2], v[3]), o[1], 0, 0, 0);
  o[2] = __builtin_amdgcn_mfma_f32_32x32x16_bf16(pa, PK(v[4], v[5]), o[2], 0, 0, 0);
  o[3] = __builtin_amdgcn_mfma_f32_32x32x16_bf16(pa, PK(v[6], v[7]), o[3], 0, 0, 0);
#undef PK
}
template <int NCB> __device__ __forceinline__ void pv_all(f32x16 (&o)[NCB], int vb, bf16x8 pa0, bf16x8 pa1, bf16x8 pa2, bf16x8 pa3) {
  if constexpr (NCB == 4) {
    s16x4 va[8], vc[8];
    v_reads_ks<4, 0>(va, vb);
    v_reads_ks<4, 1>(vc, vb); asm volatile("s_waitcnt lgkmcnt(8)" ::: "memory"); SBAR(); pv_mm_ks(o, va, pa0);
    v_reads_ks<4, 2>(va, vb); asm volatile("s_waitcnt lgkmcnt(8)" ::: "memory"); SBAR(); pv_mm_ks(o, vc, pa1);
    v_reads_ks<4, 3>(vc, vb); asm volatile("s_waitcnt lgkmcnt(8)" ::: "memory"); SBAR(); pv_mm_ks(o, va, pa2);
    asm volatile("s_waitcnt lgkmcnt(0)" ::: "memory"); SBAR(); pv_mm_ks(o, vc, pa3);
  } else {
    pv_one<NCB, 0>(o[0], vb, pa0, pa1, pa2, pa3); pv_one<NCB, 1>(o[1], vb, pa0, pa1, pa2, pa3);
  }
}

constexpr float THR = 8.f;
template <int DQK> struct ScaleOf { static constexpr float v = DQK == 64 ? 0.125f : DQK == 96 ? 0.10206207261596575f : 0.08838834764831845f; };

template <int DQK>
__device__ __forceinline__ void partialSM(f32x16& p0, f32x16& p1, float& m_reg, float& mn, float& alpha) {
  constexpr float SCALE = ScaleOf<DQK>::v, C = SCALE * LOG2E;
  float pmax = p0[0];
#pragma unroll
  for (int r = 1; r < 16; ++r) pmax = fmaxf(pmax, p0[r]);
#pragma unroll
  for (int r = 0; r < 16; ++r) pmax = fmaxf(pmax, p1[r]);
  { auto rr = __builtin_amdgcn_permlane32_swap(__float_as_uint(pmax), __float_as_uint(pmax), false, false);
    pmax = fmaxf(__uint_as_float(rr[0]), __uint_as_float(rr[1])); }
  if (__builtin_expect(__all(pmax - m_reg <= THR / SCALE), 1)) { mn = m_reg; alpha = 1.f; }
  else { mn = fmaxf(m_reg, pmax); alpha = __builtin_amdgcn_exp2f((m_reg - mn) * C); m_reg = mn; }
  const float mnC = -mn * C;
#pragma unroll
  for (int r = 0; r < 16; ++r) p0[r] = fmaf(p0[r], C, mnC);
#pragma unroll
  for (int r = 0; r < 16; ++r) p1[r] = fmaf(p1[r], C, mnC);
#pragma unroll
  for (int r = 0; r < 16; ++r) p0[r] = __builtin_amdgcn_exp2f(p0[r]);
}
__device__ __forceinline__ void finishSM(f32x16& p0, f32x16& p1, float alpha, float& l_reg, bf16x8& pa0, bf16x8& pa1, bf16x8& pa2, bf16x8& pa3) {
#pragma unroll
  for (int r = 0; r < 16; ++r) p1[r] = __builtin_amdgcn_exp2f(p1[r]);
  float ps = 0;
#pragma unroll
  for (int r = 0; r < 16; ++r) ps += p0[r];
#pragma unroll
  for (int r = 0; r < 16; ++r) ps += p1[r];
  { auto rr = __builtin_amdgcn_permlane32_swap(__float_as_uint(ps), __float_as_uint(ps), false, false);
    ps = __uint_as_float(rr[0]) + __uint_as_float(rr[1]); }
  l_reg = l_reg * alpha + ps;
#define PK4(Pv, BASE, OUT) do { unsigned a0 = cvtpk(Pv[BASE + 0], Pv[BASE + 1]), a1 = cvtpk(Pv[BASE + 2], Pv[BASE + 3]);   \
    unsigned b0 = cvtpk(Pv[BASE + 4], Pv[BASE + 5]), b1 = cvtpk(Pv[BASE + 6], Pv[BASE + 7]);                              \
    auto r0 = __builtin_amdgcn_permlane32_swap(a0, b0, false, false); auto r1 = __builtin_amdgcn_permlane32_swap(a1, b1, false, false); \
    u32x4 w = {r0[0], r1[0], r0[1], r1[1]}; OUT = *reinterpret_cast<bf16x8*>(&w); } while (0)
  PK4(p0, 0, pa0); PK4(p0, 8, pa1); PK4(p1, 0, pa2); PK4(p1, 8, pa3);
#undef PK4
}
template <int DQK>
__device__ __forceinline__ void qkt(f32x16& p0, f32x16& p1, const char* Ks, const bf16x8 (&qr)[DQK / 16], int r32, int hi) {
  constexpr int KSTR = DQK * 2 + 16;
  p0 = f32x16{}; p1 = f32x16{};
#pragma unroll
  for (int d0 = 0; d0 < DQK / 16; ++d0) { const int cb = (d0 * 16 + hi * 8) * 2;
    const bf16x8 b0 = *reinterpret_cast<const bf16x8*>(Ks + r32 * KSTR + cb);
    const bf16x8 b1 = *reinterpret_cast<const bf16x8*>(Ks + (32 + r32) * KSTR + cb);
    p0 = __builtin_amdgcn_mfma_f32_32x32x16_bf16(b0, qr[d0], p0, 0, 0, 0);
    p1 = __builtin_amdgcn_mfma_f32_32x32x16_bf16(b1, qr[d0], p1, 0, 0, 0); }
}
__device__ __forceinline__ void swa_mask(f32x16& p0, f32x16& p1, int kp0, int qpos, int hi) {
  const float ninf = -__builtin_inff();
#pragma unroll
  for (int r = 0; r < 16; ++r) {
    const int d0 = kp0 + crow(r, hi) - qpos, d1 = d0 + 32;
    if (d0 > 128 || d0 < -128) p0[r] = ninf;
    if (d1 > 128 || d1 < -128) p1[r] = ninf;
  }
}

template <int OFF> __device__ __forceinline__ bf16x8 lds_rd128(int a) {
  bf16x8 r; asm volatile("ds_read_b128 %0, %1 offset:%2" : "=&v"(r) : "v"(a), "i"(OFF) : "memory"); return r;
}
#define WAITL(n) do { asm volatile("s_waitcnt lgkmcnt(" #n ")" ::: "memory"); SBAR(); } while (0)
template <int NCB, int D0> __device__ __forceinline__ void v_reads(s16x4 (&v)[8], int vb) {
#define VOFF(ks, half) (((2 * (ks) + (half)) * NCB + D0) * 512)
  v[0] = tr_read<VOFF(0, 0)>(vb); v[1] = tr_read<VOFF(0, 1)>(vb); v[2] = tr_read<VOFF(1, 0)>(vb); v[3] = tr_read<VOFF(1, 1)>(vb);
  v[4] = tr_read<VOFF(2, 0)>(vb); v[5] = tr_read<VOFF(2, 1)>(vb); v[6] = tr_read<VOFF(3, 0)>(vb); v[7] = tr_read<VOFF(3, 1)>(vb);
#undef VOFF
}
__device__ __forceinline__ void pv_mm(f32x16& od, const s16x4 (&v)[8], bf16x8 pa0, bf16x8 pa1, bf16x8 pa2, bf16x8 pa3) {
#define PK(L, H) (bf16x8){L[0], L[1], L[2], L[3], H[0], H[1], H[2], H[3]}
  od = __builtin_amdgcn_mfma_f32_32x32x16_bf16(pa0, PK(v[0], v[1]), od, 0, 0, 0);
  od = __builtin_amdgcn_mfma_f32_32x32x16_bf16(pa1, PK(v[2], v[3]), od, 0, 0, 0);
  od = __builtin_amdgcn_mfma_f32_32x32x16_bf16(pa2, PK(v[4], v[5]), od, 0, 0, 0);
  od = __builtin_amdgcn_mfma_f32_32x32x16_bf16(pa3, PK(v[6], v[7]), od, 0, 0, 0);
#undef PK
}
template <int DQK, int DV, bool DOQK>
__device__ __forceinline__ void mseg_body(f32x16& p0, f32x16& p1, f32x16 (&o)[DV / 32], const bf16x8 (&qr)[DQK / 16], int ka, int vb,
                                          bf16x8 pa0, bf16x8 pa1, bf16x8 pa2, bf16x8 pa3) {
  constexpr int NCB = DV / 32, KSTR = DQK * 2 + 16, R2 = 32 * KSTR;
  s16x4 va[8], vc[8];
#define QK2(KA, KB, D) do { p0 = __builtin_amdgcn_mfma_f32_32x32x16_bf16(KA, qr[D], p0, 0, 0, 0); p1 = __builtin_amdgcn_mfma_f32_32x32x16_bf16(KB, qr[D], p1, 0, 0, 0); } while (0)
  if constexpr (!DOQK) {
    v_reads<NCB, 0>(va, vb); v_reads<NCB, 1>(vc, vb);
  } else if constexpr (DQK == 64) {
    const bf16x8 k0 = lds_rd128<0>(ka), k1 = lds_rd128<R2>(ka), k2 = lds_rd128<32>(ka), k3 = lds_rd128<R2 + 32>(ka);
    const bf16x8 k4 = lds_rd128<64>(ka), k5 = lds_rd128<R2 + 64>(ka), k6 = lds_rd128<96>(ka), k7 = lds_rd128<R2 + 96>(ka);
    v_reads<NCB, 0>(va, vb); WAITL(8);
    v_reads<NCB, 1>(vc, vb);
    p0 = f32x16{}; p1 = f32x16{};
    QK2(k0, k1, 0); QK2(k2, k3, 1); QK2(k4, k5, 2); QK2(k6, k7, 3);
  } else if constexpr (DQK == 96) {
    const bf16x8 k0 = lds_rd128<0>(ka), k1 = lds_rd128<R2>(ka), k2 = lds_rd128<32>(ka), k3 = lds_rd128<R2 + 32>(ka), k4 = lds_rd128<64>(ka), k5 = lds_rd128<R2 + 64>(ka);
    const bf16x8 k6 = lds_rd128<96>(ka), k7 = lds_rd128<R2 + 96>(ka), k8 = lds_rd128<128>(ka), k9 = lds_rd128<R2 + 128>(ka), k10 = lds_rd128<160>(ka), k11 = lds_rd128<R2 + 160>(ka);
    WAITL(6);
    v_reads<NCB, 0>(va, vb);
    p0 = f32x16{}; p1 = f32x16{};
    QK2(k0, k1, 0); QK2(k2, k3, 1); QK2(k4, k5, 2);
    WAITL(8);
    v_reads<NCB, 1>(vc, vb);
    QK2(k6, k7, 3); QK2(k8, k9, 4); QK2(k10, k11, 5);
  } else {
    const bf16x8 k0 = lds_rd128<0>(ka), k1 = lds_rd128<R2>(ka), k2 = lds_rd128<32>(ka), k3 = lds_rd128<R2 + 32>(ka);
    const bf16x8 k4 = lds_rd128<64>(ka), k5 = lds_rd128<R2 + 64>(ka), k6 = lds_rd128<96>(ka), k7 = lds_rd128<R2 + 96>(ka);
    v_reads<NCB, 0>(va, vb); WAITL(8);
    p0 = f32x16{}; p1 = f32x16{};
    QK2(k0, k1, 0); QK2(k2, k3, 1); QK2(k4, k5, 2); QK2(k6, k7, 3);
    const bf16x8 j0 = lds_rd128<128>(ka), j1 = lds_rd128<R2 + 128>(ka), j2 = lds_rd128<160>(ka), j3 = lds_rd128<R2 + 160>(ka);
    const bf16x8 j4 = lds_rd128<192>(ka), j5 = lds_rd128<R2 + 192>(ka), j6 = lds_rd128<224>(ka), j7 = lds_rd128<R2 + 224>(ka);
    v_reads<NCB, 1>(vc, vb); WAITL(8);
    QK2(j0, j1, 4); QK2(j2, j3, 5); QK2(j4, j5, 6); QK2(j6, j7, 7);
  }
#undef QK2
  if constexpr (NCB == 4) {
    WAITL(8); pv_mm(o[0], va, pa0, pa1, pa2, pa3);
    v_reads<NCB, 2>(va, vb); WAITL(8); pv_mm(o[1], vc, pa0, pa1, pa2, pa3);
    v_reads<NCB, 3>(vc, vb); WAITL(8); pv_mm(o[2], va, pa0, pa1, pa2, pa3);
    WAITL(0); pv_mm(o[3], vc, pa0, pa1, pa2, pa3);
  } else {
    WAITL(8); pv_mm(o[0], va, pa0, pa1, pa2, pa3);
    WAITL(0); pv_mm(o[1], vc, pa0, pa1, pa2, pa3);
  }
}

template <int DQK, bool FAST>
__device__ __forceinline__ void softmax_tile(f32x16& p0, f32x16& p1, float& m_reg, float& l_reg, float& alpha, bf16x8& pa0, bf16x8& pa1, bf16x8& pa2, bf16x8& pa3) {
  constexpr float SCALE = ScaleOf<DQK>::v, C = SCALE * LOG2E;
  if constexpr (FAST) {
#pragma unroll
    for (int r = 0; r < 16; ++r) p0[r] = __builtin_amdgcn_exp2f(p0[r]);
#pragma unroll
    for (int r = 0; r < 16; ++r) p1[r] = __builtin_amdgcn_exp2f(p1[r]);
  } else {
  float pmax = p0[0];
#pragma unroll
  for (int r = 1; r < 16; ++r) pmax = fmaxf(pmax, p0[r]);
#pragma unroll
  for (int r = 0; r < 16; ++r) pmax = fmaxf(pmax, p1[r]);
  { auto rr = __builtin_amdgcn_permlane32_swap(__float_as_uint(pmax), __float_as_uint(pmax), false, false);
    pmax = fmaxf(__uint_as_float(rr[0]), __uint_as_float(rr[1])); }
  const bool any = __any((pmax - m_reg) > THR / SCALE);
  const float mn = any ? fmaxf(m_reg, pmax) : m_reg;
  alpha = __builtin_amdgcn_exp2f((m_reg - mn) * C);
  m_reg = mn;
  const float mnC = -mn * C;
#pragma unroll
  for (int r = 0; r < 16; ++r) p0[r] = __builtin_amdgcn_exp2f(fmaf(p0[r], C, mnC));
#pragma unroll
  for (int r = 0; r < 16; ++r) p1[r] = __builtin_amdgcn_exp2f(fmaf(p1[r], C, mnC));
  }
  float ps = 0;
#pragma unroll
  for (int r = 0; r < 16; ++r) ps += p0[r];
#pragma unroll
  for (int r = 0; r < 16; ++r) ps += p1[r];
  { auto rr = __builtin_amdgcn_permlane32_swap(__float_as_uint(ps), __float_as_uint(ps), false, false);
    ps = __uint_as_float(rr[0]) + __uint_as_float(rr[1]); }
  if constexpr (FAST) l_reg += ps; else l_reg = l_reg * alpha + ps;
#define PK4(Pv, BASE, OUT) do { u32x4 w = {cvtpk(Pv[BASE + 0], Pv[BASE + 1]), cvtpk(Pv[BASE + 2], Pv[BASE + 3]), cvtpk(Pv[BASE + 4], Pv[BASE + 5]), cvtpk(Pv[BASE + 6], Pv[BASE + 7])}; \
    OUT = *reinterpret_cast<bf16x8*>(&w); } while (0)
  PK4(p0, 0, pa0); PK4(p0, 8, pa1); PK4(p1, 0, pa2); PK4(p1, 8, pa3);
#undef PK4
}

template <int DQK, int DV, bool SWA, bool FAST>
__device__ __forceinline__ bool attn_core(f32x16 (&o)[DV / 32], const bf16x8 (&qr)[DQK / 16],
    const bf16_t* __restrict__ Kp, int ldk, const bf16_t* __restrict__ Kp2, int ldk2, const bf16_t* __restrict__ Vp, int ldv,
    int NT, int NL, int lo, int qpos, float sink_l2, char* lds) {
  constexpr int NCB = DV / 32, KSTR = DQK * 2 + 16, SHM_K = 64 * KSTR, SHM_V = 64 * DV * 2;
  constexpr int NKC = DQK == 64 ? 1 : 2, NVC = DV / 64;
  constexpr float SCALE = ScaleOf<DQK>::v, C = SCALE * LOG2E;
  int tid = threadIdx.x; LAUNDER_V(tid);
  const int wid = tid >> 6, lane = tid & 63, r32 = lane & 31, hi = lane >> 5;
  const bool grp1 = (wid & 4) != 0;
  char* V_lds = lds; char* K_lds = lds + 4 * SHM_V;
  float* wsf = (float*)(lds + 4 * SHM_V + 4 * SHM_K) + wid * 64; float* li_l = wsf; float* al_l = wsf + 32;
  float m_reg = -1e30f, l_reg = 0.f, alpha = 1.f;
#pragma unroll
  for (int d = 0; d < NCB; ++d) o[d] = f32x16{};
  unsigned ko[NKC]; int kl[NKC]; unsigned vo[NVC]; int vl[NVC];
  if constexpr (DQK == 128) {
#pragma unroll
    for (int i = 0; i < 2; ++i) { const int row = (tid >> 4) + 32 * i, c = tid & 15; ko[i] = (unsigned)(row * ldk + c * 8) * 2u; kl[i] = row * KSTR + c * 16; }
  } else if constexpr (DQK == 64) {
    const int row = tid >> 3, c = tid & 7; ko[0] = (unsigned)(row * ldk + c * 8) * 2u; kl[0] = row * KSTR + c * 16;
  } else {
    { const int row = tid >> 3, c = tid & 7; ko[0] = (unsigned)(row * ldk + c * 8) * 2u; kl[0] = row * KSTR + c * 16; }
    { const int t2 = tid & 255; const int row = t2 >> 2, c = t2 & 3; ko[1] = (unsigned)(row * ldk2 + c * 8) * 2u; kl[1] = row * KSTR + (8 + c) * 16; }
  }
  if constexpr (DV == 128) {
#pragma unroll
    for (int i = 0; i < 2; ++i) { const int row = (tid >> 4) + 32 * i, c = (tid & 15) * 8; vo[i] = (unsigned)(row * ldv + c) * 2u; vl[i] = v_st<NCB>(row, c); }
  } else {
    const int row = tid >> 3, c = (tid & 7) * 8; vo[0] = (unsigned)(row * ldv + c) * 2u; vl[0] = v_st<NCB>(row, c);
  }
  const int vb0 = (int)(uintptr_t)V_lds + v_rd_base(lane);
  const int ka0 = (int)(uintptr_t)K_lds + r32 * KSTR + hi * 16;
  bf16x8 sk[2][NKC], sv[2][NVC];
#define TROW(j) ((j) < NL ? lo + 64 * (j) : SEQ + 64 * ((j) - NL))
#define SLOAD(s, j) do { const size_t ro_ = (size_t)TROW(j); const char* kb_ = (const char*)Kp + ro_ * ldk * 2; const char* vb_ = (const char*)Vp + ro_ * ldv * 2; \
    sk[s][0] = *(const bf16x8*)(kb_ + ko[0]); \
    if constexpr (DQK == 128) sk[s][NKC - 1] = *(const bf16x8*)(kb_ + ko[NKC - 1]); \
    if constexpr (DQK == 96) sk[s][NKC - 1] = *(const bf16x8*)((const char*)Kp2 + ro_ * ldk2 * 2 + ko[NKC - 1]); \
    _Pragma("unroll") for (int i_ = 0; i_ < NVC; ++i_) sv[s][i_] = *(const bf16x8*)(vb_ + vo[i_]); } while (0)
#define SWRITE(slot, s) do { _Pragma("unroll") for (int i_ = 0; i_ < NVC; ++i_) *(bf16x8*)(V_lds + (slot) * SHM_V + vl[i_]) = sv[s][i_]; \
    _Pragma("unroll") for (int i_ = 0; i_ < NKC; ++i_) *(bf16x8*)(K_lds + (slot) * SHM_K + kl[i_]) = sk[s][i_]; } while (0)
#define RESC(a) do { if (__any((a) < 1.f)) { if (hi == 0) al_l[r32] = (a); asm volatile("s_waitcnt lgkmcnt(0)" ::: "memory"); \
    _Pragma("unroll") for (int d = 0; d < NCB; ++d) _Pragma("unroll") for (int r = 0; r < 16; ++r) o[d][r] *= al_l[crow(r, hi)]; } } while (0)
#define MASK(pa_, pb_, j) do { if constexpr (SWA) { if ((j) < NL) swa_mask(pa_, pb_, lo + 64 * (j), qpos, hi); } } while (0)
#define VSEG(t, DOQK_) do { SBAR(); softmax_tile<DQK, FAST>(pn0, pn1, m_reg, l_reg, alpha, pa0, pa1, pa2, pa3); if constexpr (!FAST) RESC(alpha); \
    if (DOQK_) { qkt<DQK>(pn0, pn1, K_lds + (((t) + 1) & 3) * SHM_K, qr, r32, hi); MASK(pn0, pn1, (t) + 1); }     \
    SBAR(); __syncthreads(); } while (0)
#define MSEG(t, STG) do { SBAR(); __builtin_amdgcn_s_setprio(2); \
    if ((t) + 3 < NT) { SWRITE(((t) + 3) & 3, STG); if ((t) + 5 < NT) SLOAD(STG, (t) + 5); } \
    const int vbt_ = vb0 + ((t) & 3) * SHM_V; \
    if constexpr (DV == 64) mseg_body<DQK, DV, false>(pn0, pn1, o, qr, ka0, vbt_, pa0, pa1, pa2, pa3); \
    else pv_all<NCB>(o, vbt_, pa0, pa1, pa2, pa3); \
    __builtin_amdgcn_s_setprio(0); SBAR(); __syncthreads(); } while (0)
  f32x16 pn0, pn1; bf16x8 pa0, pa1, pa2, pa3;
  SLOAD(0, 0); SLOAD(1, 1);
  SWRITE(0, 0); if (2 < NT) SLOAD(0, 2);
  SWRITE(1, 1); if (3 < NT) SLOAD(1, 3);
  __syncthreads();
  if (grp1) __syncthreads();
  if (2 < NT) { SWRITE(2, 0); if (4 < NT) SLOAD(0, 4); }
  qkt<DQK>(pn0, pn1, K_lds, qr, r32, hi); MASK(pn0, pn1, 0);
  __syncthreads();
  for (int t = 0; t + 2 < NT; t += 2) {
    VSEG(t, 1); MSEG(t, 1);
    VSEG(t + 1, 1); MSEG(t + 1, 0);
  }
  VSEG(NT - 2, 1); MSEG(NT - 2, 1);
  VSEG(NT - 1, 0); MSEG(NT - 1, 0);
  if (!grp1) __syncthreads();
  if constexpr (SWA) l_reg += FAST ? __builtin_amdgcn_exp2f(sink_l2) : __builtin_amdgcn_exp2f(sink_l2 - m_reg * C);
  const bool bad = __any(!(l_reg > 1.0e-20f && l_reg < 1.0e30f));
  if (hi == 0) li_l[r32] = l_reg; asm volatile("s_waitcnt lgkmcnt(0)" ::: "memory");
#pragma unroll
  for (int r = 0; r < 16; ++r) { const float rl = __builtin_amdgcn_rcpf(li_l[crow(r, hi)]);
#pragma unroll
    for (int d = 0; d < NCB; ++d) o[d][r] *= rl; }
  __syncthreads();
  return bad;
#undef TROW
#undef SLOAD
#undef SWRITE
#undef RESC
#undef MASK
#undef VSEG
#undef MSEG
}

__device__ __forceinline__ void scale8(bf16x8& v, float c) { float f[8]; unpack8(v, f);
#pragma unroll
  for (int e = 0; e < 8; ++e) f[e] *= c;
  v = pack8(f); }
__device__ __forceinline__ bool wg_any(bool flag, char* lds) {
  volatile int* w = (volatile int*)lds;
  if (threadIdx.x == 0) w[0] = 0;
  __syncthreads();
  if (flag && (threadIdx.x & 63) == 0) w[0] = 1;
  __syncthreads();
  const bool r = w[0] != 0;
  __syncthreads();
  return r;
}
#define ATTN_PASS(DQK_, DV_, SWA_, ...) do { constexpr float Cq_ = ScaleOf<DQK_>::v * LOG2E; \
    _Pragma("unroll") for (int d0 = 0; d0 < DQK_ / 16; ++d0) scale8(qr[d0], Cq_); \
    bool bad_ = attn_core<DQK_, DV_, SWA_, true>(__VA_ARGS__); \
    if (wg_any(bad_, lds)) { _Pragma("unroll") for (int d0 = 0; d0 < DQK_ / 16; ++d0) scale8(qr[d0], 1.f / Cq_); \
      attn_core<DQK_, DV_, SWA_, false>(__VA_ARGS__); } } while (0)

template <int KIND>
__device__ __forceinline__ void attn_item(const P& p, int b, int h, int qb, bool is_ctx, char* lds) {
  constexpr int DQK = KIND == 0 ? 96 : KIND == 2 ? 128 : 64;
  constexpr int DV = (KIND == 1 || KIND == 2) ? 128 : 64;
  constexpr int NCB = DV / 32;
  int tid = threadIdx.x; LAUNDER_V(tid);
  const int wid = tid >> 6, lane = tid & 63, r32 = lane & 31, hi = lane >> 5;
  const int rowb = b * TPB;
  const int q_t0 = is_ctx ? SEQ : qb * 256;
  const int qt = q_t0 + wid * 32 + r32;
  const size_t qrow = (size_t)rowb + qt;
  const int krow0 = is_ctx ? rowb + SEQ : rowb;
  int NT, NL, lo;
  if (is_ctx) { NT = 4; NL = 4; lo = 0; }
  else if (KIND == 3) { lo = q_t0 - 128 < 0 ? 0 : q_t0 - 128; const int he = q_t0 + 384 > SEQ ? SEQ : q_t0 + 384; NL = (he - lo) / 64; NT = NL + 4; }
  else { NT = TPB / 64; NL = NT; lo = 0; }
  const float* rt = (const float*)(p.ws + WS_ROPE);
  const bf16_t* proj = (const bf16_t*)(p.ws + WS_PROJ);
  bf16_t* ob = (bf16_t*)(p.ws + WS_ABUF);
  const int prow = qt >> 6, pcol = qt & 63;
  f32x16 o[NCB];

  if constexpr (KIND == 1) {
    const float lam = ((const float*)(p.ws + WS_MISC))[0];
#pragma unroll 1
    for (int map = 0; map < 2; ++map) {
      const int m = 2 * h + map;
      bf16x8 qr[4];
      { const bf16_t* qp = proj + qrow * NPAD1 + m * 64 + hi * 8;
#pragma unroll
        for (int d0 = 0; d0 < 4; ++d0) qr[d0] = *(const bf16x8*)(qp + d0 * 16); }
      if (!is_ctx) {
        const float* T = rt + ROPE64_OFF;
        rope8(qr[0], qr[2], T + prow * 16 + hi * 8, T + 256 * 16 + prow * 16 + hi * 8);
        rope8(qr[1], qr[3], T + pcol * 16 + hi * 8, T + 256 * 16 + pcol * 16 + hi * 8);
      }
      ATTN_PASS(64, 128, false, o, qr, proj + (size_t)krow0 * NPAD1 + 1024 + m * 64, NPAD1, nullptr, 0,
                proj + (size_t)krow0 * NPAD1 + 2048 + h * 128, NPAD1, NT, NL, lo, qt, 0.f, lds);
      char* obw = (char*)(ob + ((size_t)rowb + q_t0) * 1024 + h * 128);
      const char* gbw = (const char*)(proj + ((size_t)rowb + q_t0) * NPAD1 + 3072 + h * 128);
      int te = threadIdx.x; LAUNDER_V(te);
      const int wid = te >> 6, r32 = te & 31, hi = (te >> 5) & 1;
      const unsigned oo = (unsigned)((wid * 32 + 4 * hi) * 1024 + r32) * 2u;
      const unsigned go = (unsigned)((wid * 32 + 4 * hi) * NPAD1 + r32) * 2u;
      if (map == 0) {
#pragma unroll
        for (int r = 0; r < 16; ++r) {
          const unsigned ro = oo + (unsigned)(((r & 3) + 8 * (r >> 2)) * 2048);
#pragma unroll
          for (int d = 0; d < 4; ++d) *(bf16_t*)(obw + ro + d * 64) = f2bf(o[d][r]);
          if ((r & 3) == 3) SBAR();
        }
      } else {
        float gs[4];
#pragma unroll
        for (int d = 0; d < 4; ++d) gs[d] = p.diff_g_sub[d * 32 + r32] * (1.f - LAMBDA_INIT);
#pragma unroll
        for (int r = 0; r < 16; ++r) {
          const unsigned ro = oo + (unsigned)(((r & 3) + 8 * (r >> 2)) * 2048);
          const unsigned rg = go + (unsigned)(((r & 3) + 8 * (r >> 2)) * (NPAD1 * 2));
          float dv[4]; float ss = 0.f;
#pragma unroll
          for (int d = 0; d < 4; ++d) { const float o1 = bf2f((short)*(const bf16_t*)(obw + ro + d * 64)); dv[d] = o1 - lam * o[d][r]; ss += dv[d] * dv[d]; }
          ss += __shfl_xor(ss, 1); ss += __shfl_xor(ss, 2); ss += __shfl_xor(ss, 4); ss += __shfl_xor(ss, 8); ss += __shfl_xor(ss, 16);
          const float rstd = rsqrtf(ss * (1.f / 128.f) + EPS);
#pragma unroll
          for (int d = 0; d < 4; ++d) {
            const float g = bf2f((short)*(const bf16_t*)(gbw + rg + d * 64));
            *(bf16_t*)(obw + ro + d * 64) = f2bf(dv[d] * rstd * gs[d] * silu_f(g));
          }
          if ((r & 1) == 1) SBAR();
        }
      }
    }
  } else {
    bf16x8 qr[DQK / 16];
    const bf16_t *Kp, *Kp2 = nullptr, *Vp, *gbase; int ldk, ldk2 = 0, ldv, ldg; float sink_l2 = 0.f;
    if constexpr (KIND == 0) {
      const bf16_t* q2 = (const bf16_t*)(p.ws + WS_X); const bf16_t* kv2 = (const bf16_t*)(p.ws + WS_KV2);
      const bf16_t* qp = q2 + qrow * 1536 + h * 96 + hi * 8;
#pragma unroll
      for (int d0 = 0; d0 < 6; ++d0) qr[d0] = *(const bf16x8*)(qp + d0 * 16);
      if (!is_ctx) { const int pos = hi ? pcol : prow; const float* T = rt + ROPE32_OFF; rope8(qr[4], qr[5], T + pos * 8, T + 256 * 8 + pos * 8); }
      Kp = kv2 + (size_t)krow0 * 2048 + h * 128; ldk = 2048; Kp2 = proj + (size_t)krow0 * NPAD0 + 384; ldk2 = NPAD0;
      Vp = kv2 + (size_t)krow0 * 2048 + h * 128 + 64; ldv = 2048;
      gbase = proj + ((size_t)rowb + q_t0) * NPAD0 + 416 + h * 64; ldg = NPAD0;
    } else if constexpr (KIND == 2) {
      const bf16_t* qp = proj + qrow * NPAD2 + h * 128 + hi * 8;
      float ss = 0.f; float xf[8][8];
#pragma unroll
      for (int d0 = 0; d0 < 8; ++d0) { unpack8(*(const bf16x8*)(qp + d0 * 16), xf[d0]);
#pragma unroll
        for (int e = 0; e < 8; ++e) ss += xf[d0][e] * xf[d0][e]; }
      ss += __shfl_xor(ss, 32);
      const float rstd = rsqrtf(ss * (1.f / 128.f) + EPS);
#pragma unroll
      for (int d0 = 0; d0 < 8; ++d0) {
        const f32x4 g0 = *(const f32x4*)(p.gqa_g_q + d0 * 16 + hi * 8), g1 = *(const f32x4*)(p.gqa_g_q + d0 * 16 + hi * 8 + 4);
#pragma unroll
        for (int e = 0; e < 8; ++e) xf[d0][e] *= rstd * (e < 4 ? g0[e & 3] : g1[e & 3]);
      }
      if (!is_ctx) {
        const float* T = rt + ROPE128_OFF;
#pragma unroll
        for (int d0 = 0; d0 < 4; ++d0) { const int pos = d0 < 2 ? prow : pcol; const int f0 = (d0 & 1) * 16 + hi * 8;
          rope8f(xf[d0], xf[d0 + 4], T + pos * 32 + f0, T + 256 * 32 + pos * 32 + f0); }
      }
#pragma unroll
      for (int d0 = 0; d0 < 8; ++d0) qr[d0] = pack8(xf[d0]);
      const int kvh = h >> 2;
      Kp = proj + (size_t)krow0 * NPAD2 + 1024 + kvh * 128; ldk = NPAD2; Vp = proj + (size_t)krow0 * NPAD2 + 1280 + kvh * 128; ldv = NPAD2;
      gbase = proj + ((size_t)rowb + q_t0) * NPAD2 + 1536 + h * 128; ldg = NPAD2;
    } else {
      const bf16_t* qp = proj + qrow * NPAD3 + h * 64 + hi * 8;
#pragma unroll
      for (int d0 = 0; d0 < 4; ++d0) qr[d0] = *(const bf16x8*)(qp + d0 * 16);
      if (!is_ctx) {
        const float* T = rt + ROPE64_OFF;
        rope8(qr[0], qr[2], T + prow * 16 + hi * 8, T + 256 * 16 + prow * 16 + hi * 8);
        rope8(qr[1], qr[3], T + pcol * 16 + hi * 8, T + 256 * 16 + pcol * 16 + hi * 8);
      }
      const int kvh = h >> 3;
      Kp = proj + (size_t)krow0 * NPAD3 + 1024 + kvh * 64; ldk = NPAD3; Vp = proj + (size_t)krow0 * NPAD3 + 1152 + kvh * 64; ldv = NPAD3;
      gbase = proj + ((size_t)rowb + q_t0) * NPAD3 + 1280 + h * 64; ldg = NPAD3;
      sink_l2 = p.swa_sink[h] * LOG2E;
    }
    ATTN_PASS(DQK, DV, KIND == 3, o, qr, Kp, ldk, Kp2, ldk2, Vp, ldv, NT, NL, lo, qt, sink_l2, lds);
    char* obw = (char*)(ob + ((size_t)rowb + q_t0) * 1024 + h * DV);
    const char* gbw = (const char*)gbase;
    int te = threadIdx.x; LAUNDER_V(te);
    const int wid2 = te >> 6, r32b = te & 31, hi2 = (te >> 5) & 1;
    const unsigned oo = (unsigned)((wid2 * 32 + 4 * hi2) * 1024 + r32b) * 2u;
    const unsigned go = (unsigned)((wid2 * 32 + 4 * hi2) * ldg + r32b) * 2u;
#pragma unroll
    for (int r = 0; r < 16; ++r) {
      const unsigned ro = oo + (unsigned)(((r & 3) + 8 * (r >> 2)) * 2048);
      const unsigned rg = go + (unsigned)(((r & 3) + 8 * (r >> 2)) * ldg * 2);
#pragma unroll
      for (int d = 0; d < NCB; ++d) {
        const float g = bf2f((short)*(const bf16_t*)(gbw + rg + d * 64));
        *(bf16_t*)(obw + ro + d * 64) = f2bf(o[d][r] * silu_f(g));
      }
      if ((r & 3) == 3) SBAR();
    }
  }
}

template <int KIND>
__device__ __forceinline__ void phase_attn(const P& p, char* lds) {
  constexpr int H = (KIND == 0 || KIND == 3) ? 16 : 8;
  constexpr int nlat = NBATCH * H * 64, nctx = KIND < 3 ? NBATCH * H : 0;
  for (int it = blockIdx.x; it < nlat + nctx; it += gridDim.x) {
    if (it < nlat) {
      int qb = it & 63, hh = it >> 6;
      if (gridDim.x == 256) {
        const int x = it & 7, j = (it & 255) >> 3; hh = (it >> 8) * 4 + (x >> 1); qb = j + 32 * (x & 1);
      }
      attn_item<KIND>(p, hh / H, hh % H, qb, false, lds);
    }
    else { const int j = it - nlat; attn_item<KIND>(p, j / H, j % H, 0, true, lds); }
  }
}

__device__ __forceinline__ P load_params() {
#if defined(__HIP_DEVICE_COMPILE__)
  auto pp = (const __attribute__((address_space(4))) P*)__builtin_amdgcn_kernarg_segment_ptr();
  asm volatile("" : "+s"(pp));
  return *pp;
#else
  return P{};
#endif
}
__global__ __launch_bounds__(NTHR) void mega(P p_unused) {
  extern __shared__ __attribute__((aligned(16))) char lds[];
  cg::grid_group grid = cg::this_grid();
  phase_prep(load_params(), lds); grid.sync();
#define GSYNC(k) grid_barrier((unsigned*)(load_params().ws + WS_BAR), (unsigned)(k))
  phase_h0(load_params()); GSYNC(1);
#pragma unroll 1
  for (int layer = 0; layer < 4; ++layer) {
    const int e0 = 2 + 5 * layer;
    phase_gemm1(load_params(), layer, lds); GSYNC(e0);
    if (layer == 0) { phase_kfix<0>(load_params()); phase_gemm2(load_params(), lds); }
    else if (layer == 1) phase_kfix<1>(load_params());
    else if (layer == 2) phase_kfix<2>(load_params());
    else phase_kfix<3>(load_params());
    GSYNC(e0 + 1);
    if (layer == 0) phase_attn<0>(load_params(), lds);
    else if (layer == 1) phase_attn<1>(load_params(), lds);
    else if (layer == 2) phase_attn<2>(load_params(), lds);
    else phase_attn<3>(load_params(), lds);
    GSYNC(e0 + 2);
    phase_outproj(load_params(), layer, lds); GSYNC(e0 + 3);
    phase_ln(load_params(), layer);
    if (layer < 3) GSYNC(e0 + 4);
  }
}

extern "C" void kernel_launch(void* const* d_in, const int* in_sizes, int n_in, void* d_out, int out_size, void* d_ws, size_t ws_size, hipStream_t stream) {
  static int grid_blocks = 0;
  if (!grid_blocks) {
    if (ws_size < WS_END) { fprintf(stderr, "kernel_launch: workspace too small: %zu < %zu\n", ws_size, (size_t)WS_END); return; }
    if (hipFuncSetAttribute((const void*)mega, hipFuncAttributeMaxDynamicSharedMemorySize, LDS_BYTES) != hipSuccess) { fprintf(stderr, "kernel_launch: LDS attribute failed\n"); return; }
    int dev = 0, cus = 0, per_cu = 0;
    hipGetDevice(&dev);
    hipDeviceGetAttribute(&cus, hipDeviceAttributeMultiprocessorCount, dev);
    hipOccupancyMaxActiveBlocksPerMultiprocessor(&per_cu, mega, NTHR, LDS_BYTES);
    if (per_cu < 1) { fprintf(stderr, "kernel_launch: occupancy 0\n"); return; }
    grid_blocks = cus * 1;
  }
  P p{};
  p.x = (const float*)d_in[0]; p.c = (const float*)d_in[1]; p.ctx = (const float*)d_in[2]; p.c_ctx = (const float*)d_in[3];
  p.ada_w = (const float*)d_in[4]; p.ada_b = (const float*)d_in[5]; p.out_w = (const float*)d_in[6]; p.ln_g = (const float*)d_in[7]; p.ln_b = (const float*)d_in[8];
  p.mla_w_in = (const float*)d_in[9]; p.mla_g_qa = (const float*)d_in[10]; p.mla_w_qb = (const float*)d_in[11]; p.mla_g_kva = (const float*)d_in[12]; p.mla_w_kvb = (const float*)d_in[13];
  p.diff_w_in = (const float*)d_in[14]; p.diff_lambda = (const float*)d_in[15]; p.diff_g_sub = (const float*)d_in[16];
  p.gqa_w_in = (const float*)d_in[17]; p.gqa_g_q = (const float*)d_in[18]; p.gqa_g_k = (const float*)d_in[19];
  p.swa_w_in = (const float*)d_in[20]; p.swa_sink = (const float*)d_in[21];
  p.out = (float*)d_out; p.ws = (char*)d_ws;
  hipMemsetAsync((char*)d_ws + WS_BAR, 0, 256, stream);
  void* args[] = {&p};
  hipError_t e = hipLaunchCooperativeKernel((const void*)mega, dim3(grid_blocks), dim3(NTHR), args, LDS_BYTES, stream);
  if (e != hipSuccess) fprintf(stderr, "cooperative launch failed: %s (grid %d)\n", hipGetErrorString(e), grid_blocks);
}
```

```cpp
#include <hip/hip_runtime.h>
#include <hip/hip_cooperative_groups.h>
#include <cstdio>
#include <cstdint>
namespace cg = cooperative_groups;

typedef unsigned short bf16_t;
using bf16x8 = __attribute__((ext_vector_type(8))) short;
using s16x4  = __attribute__((ext_vector_type(4))) short;
using f32x16 = __attribute__((ext_vector_type(16))) float;
using f32x4  = __attribute__((ext_vector_type(4))) float;
using u32x4  = __attribute__((ext_vector_type(4))) unsigned;
using u32x2  = __attribute__((ext_vector_type(2))) unsigned;

constexpr int DM = 1024, NBATCH = 2, SEQ = 16384, CTXL = 256, TPB = SEQ + CTXL, NROW = NBATCH * TPB;
constexpr int NTHR = 512;
constexpr float EPS = 1e-6f;
constexpr float ALPHA = 1.681792830507429f;
constexpr float LAMBDA_INIT = 0.35550906759096544f;
constexpr float LOG2E = 1.4426950408889634f;

constexpr size_t al256(size_t x) { return (x + 255) / 256 * 256; }
constexpr int NPAD0 = 1536, NPAD1 = 4096, NPAD2 = 2560, NPAD3 = 2304;
constexpr size_t WS_WIN0 = 0;
constexpr size_t WS_WIN1 = WS_WIN0 + (size_t)NPAD0 * 1024 * 2;
constexpr size_t WS_WIN2 = WS_WIN1 + (size_t)NPAD1 * 1024 * 2;
constexpr size_t WS_WIN3 = WS_WIN2 + (size_t)NPAD2 * 1024 * 2;
constexpr size_t WS_WOUT = WS_WIN3 + (size_t)NPAD3 * 1024 * 2;
constexpr size_t WS_WQB  = WS_WOUT + (size_t)4 * 1024 * 1024 * 2;
constexpr size_t WS_WKVB = WS_WQB + (size_t)1536 * 256 * 2;
constexpr size_t WS_MOD  = WS_WKVB + (size_t)2048 * 128 * 2;
constexpr size_t WS_ROPE = WS_MOD + (size_t)4 * 3 * 3072 * 4;
constexpr int ROPE32_OFF = 0, ROPE64_OFF = 256 * 8 * 2, ROPE128_OFF = ROPE64_OFF + 256 * 16 * 2, ROPE_TOTAL = ROPE128_OFF + 256 * 32 * 2;
constexpr size_t WS_MISC = WS_ROPE + (size_t)ROPE_TOTAL * 4;
constexpr size_t WS_BAR  = al256(WS_MISC + 256);
constexpr size_t WS_ABUF = al256(WS_BAR + 256);
constexpr size_t WS_X    = WS_ABUF + (size_t)NROW * 1024 * 2;
constexpr size_t WS_PROJ = WS_X + (size_t)NROW * 1024 * 4;
constexpr size_t WS_KV2  = WS_PROJ + (size_t)NROW * 1536 * 2;
constexpr size_t WS_END  = WS_PROJ + (size_t)NROW * 4096 * 2;

constexpr int LDS_BYTES = 143360;

struct P {
  const float *x, *c, *ctx, *c_ctx, *ada_w, *ada_b, *out_w, *ln_g, *ln_b;
  const float *mla_w_in, *mla_g_qa, *mla_w_qb, *mla_g_kva, *mla_w_kvb;
  const float *diff_w_in, *diff_lambda, *diff_g_sub;
  const float *gqa_w_in, *gqa_g_q, *gqa_g_k;
  const float *swa_w_in, *swa_sink;
  float* out; char* ws;
};

#define SBAR() __builtin_amdgcn_sched_barrier(0)
#define LAUNDER_V(x) asm volatile("" : "+v"(x))
__device__ __forceinline__ int crow(int r, int hi) { return (r & 3) + 8 * (r >> 2) + 4 * hi; }
__device__ __forceinline__ unsigned cvtpk(float lo, float hi) {
  unsigned r; asm volatile("v_cvt_pk_bf16_f32 %0, %1, %2" : "=v"(r) : "v"(lo), "v"(hi)); return r;
}
__device__ __forceinline__ float bf2f(short v) { return __uint_as_float(((unsigned)(unsigned short)v) << 16); }
__device__ __forceinline__ bf16_t f2bf(float f) { return (bf16_t)(cvtpk(f, f) & 0xffffu); }
__device__ __forceinline__ float silu_f(float v) { return v / (1.f + __expf(-v)); }

__device__ __forceinline__ void grid_barrier(unsigned* ctr, unsigned epoch) {
  asm volatile("s_waitcnt vmcnt(0) lgkmcnt(0)" ::: "memory");
  __syncthreads();
  if (threadIdx.x == 0) {
    __builtin_amdgcn_fence(__ATOMIC_RELEASE, "agent");
    asm volatile("s_waitcnt vmcnt(0)" ::: "memory");
    __hip_atomic_fetch_add(ctr, 1u, __ATOMIC_RELAXED, __HIP_MEMORY_SCOPE_AGENT);
    const unsigned target = epoch * gridDim.x;
    while (__hip_atomic_load(ctr, __ATOMIC_RELAXED, __HIP_MEMORY_SCOPE_AGENT) < target) __builtin_amdgcn_s_sleep(1);
    __builtin_amdgcn_fence(__ATOMIC_ACQUIRE, "agent");
    asm volatile("s_waitcnt vmcnt(0)" ::: "memory");
  }
  __syncthreads();
}

__device__ __forceinline__ void transpose_tile(const float* __restrict__ src, int K, int N, bf16_t* __restrict__ dst, const float* __restrict__ gain, int tk, int tn, float* tile) {
  int tid = threadIdx.x; LAUNDER_V(tid);
  {
    const int n = tid & 63, kb = tid >> 6;
#pragma unroll
    for (int i = 0; i < 8; ++i) {
      const int k = kb + 8 * i; const int gn = tn * 64 + n, gk = tk * 64 + k;
      float v = 0.f;
      if (gn < N) { v = src[(size_t)gk * N + gn]; if (gain) v *= gain[gk]; }
      tile[k * 65 + n] = v;
    }
  }
  __syncthreads();
  {
    const int kk = (tid & 31) * 2, nb = tid >> 5;
#pragma unroll
    for (int i = 0; i < 4; ++i) {
      const int nn = nb + 16 * i;
      const unsigned w = cvtpk(tile[kk * 65 + nn], tile[(kk + 1) * 65 + nn]);
      *(unsigned*)(dst + (size_t)(tn * 64 + nn) * K + tk * 64 + kk) = w;
    }
  }
  __syncthreads();
}

__device__ __forceinline__ void phase_prep(const P& p, char* lds) {
  int tid = threadIdx.x; LAUNDER_V(tid);
  float* tile = (float*)lds;
  constexpr int T0 = 16 * 24, T1 = 16 * 64, T2 = 16 * 40, T3 = 16 * 36, TO = 16 * 16, TQ = 4 * 24, TK = 2 * 32;
  constexpr int E0 = T0, E1 = E0 + T1, E2 = E1 + T2, E3 = E2 + T3, E4 = E3 + 4 * TO, E5 = E4 + TQ, E6 = E5 + TK;
  for (int t = blockIdx.x; t < E6; t += gridDim.x) {
    const float* src; int K, N, NP; bf16_t* dst; const float* gain = nullptr; int lt;
    if (t < E0)      { lt = t;      src = p.mla_w_in;  K = 1024; N = 1440; NP = NPAD0; dst = (bf16_t*)(p.ws + WS_WIN0); }
    else if (t < E1) { lt = t - E0; src = p.diff_w_in; K = 1024; N = 4096; NP = NPAD1; dst = (bf16_t*)(p.ws + WS_WIN1); }
    else if (t < E2) { lt = t - E1; src = p.gqa_w_in;  K = 1024; N = 2560; NP = NPAD2; dst = (bf16_t*)(p.ws + WS_WIN2); }
    else if (t < E3) { lt = t - E2; src = p.swa_w_in;  K = 1024; N = 2304; NP = NPAD3; dst = (bf16_t*)(p.ws + WS_WIN3); }
    else if (t < E4) { lt = t - E3; const int l = lt / TO; lt -= l * TO; src = p.out_w + (size_t)l * 1024 * 1024; K = 1024; N = 1024; NP = 1024; dst = (bf16_t*)(p.ws + WS_WOUT) + (size_t)l * 1024 * 1024; }
    else if (t < E5) { lt = t - E4; src = p.mla_w_qb;  K = 256; N = 1536; NP = 1536; dst = (bf16_t*)(p.ws + WS_WQB); gain = p.mla_g_qa; }
    else             { lt = t - E5; src = p.mla_w_kvb; K = 128; N = 2048; NP = 2048; dst = (bf16_t*)(p.ws + WS_WKVB); gain = p.mla_g_kva; }
    const int ntn = NP / 64; const int tk = lt / ntn, tn = lt % ntn;
    transpose_tile(src, K, N, dst, gain, tk, tn, tile);
  }
  {
    float* sv = (float*)lds;
    float* red = (float*)lds + 3072;
    for (int i = tid; i < 3072; i += NTHR) {
      const int v = i >> 10, k = i & 1023;
      const float cv = v == 0 ? p.c[k] : v == 1 ? p.c[1024 + k] : p.c_ctx[k];
      sv[i] = silu_f(cv);
    }
    __syncthreads();
    for (int it = blockIdx.x; it < 4 * 48; it += gridDim.x) {
      const int l = it / 48, n0 = (it % 48) * 64;
      const int n = tid & 63, kc = tid >> 6;
      const float* w = p.ada_w + (size_t)l * 1024 * 3072 + (size_t)(kc * 128) * 3072 + n0 + n;
      float a0 = 0.f, a1 = 0.f, a2 = 0.f;
#pragma unroll 8
      for (int k = 0; k < 128; ++k) {
        const float wv = w[(size_t)k * 3072];
        a0 += sv[kc * 128 + k] * wv; a1 += sv[1024 + kc * 128 + k] * wv; a2 += sv[2048 + kc * 128 + k] * wv;
      }
      red[(kc * 64 + n) * 3 + 0] = a0; red[(kc * 64 + n) * 3 + 1] = a1; red[(kc * 64 + n) * 3 + 2] = a2;
      __syncthreads();
      if (tid < 192) {
        const int v = tid >> 6, nn = tid & 63; float s = 0.f;
#pragma unroll
        for (int q = 0; q < 8; ++q) s += red[(q * 64 + nn) * 3 + v];
        s += p.ada_b[l * 3072 + n0 + nn];
        ((float*)(p.ws + WS_MOD))[(l * 3 + v) * 3072 + n0 + nn] = s;
      }
      __syncthreads();
    }
  }
  {
    float* rt = (float*)(p.ws + WS_ROPE);
    const int gt = blockIdx.x * NTHR + tid;
    for (int i = gt; i < 256 * 56; i += gridDim.x * NTHR) {
      const int pos = i / 56, j = i % 56;
      int nf, f, off;
      if (j < 8) { nf = 8; f = j; off = ROPE32_OFF; } else if (j < 24) { nf = 16; f = j - 8; off = ROPE64_OFF; } else { nf = 32; f = j - 24; off = ROPE128_OFF; }
      const float inv = exp2f(-(float)f / (float)nf * 13.287712379549449f);
      const float ang = (float)pos * inv;
      const float kq = rintf(ang * 0.15915494309189535f);
      float r = fmaf(-kq, 6.28318548202514648f, ang); r = fmaf(-kq, -1.7484555e-07f, r);
      rt[off + pos * nf + f] = cosf(r); rt[off + 256 * nf + pos * nf + f] = sinf(r);
    }
    if (blockIdx.x == 0 && tid < 64) {
      const float* lm = p.diff_lambda;
      float s1 = lm[tid] * lm[64 + tid], s2 = lm[128 + tid] * lm[192 + tid];
#pragma unroll
      for (int o = 32; o >= 1; o >>= 1) { s1 += __shfl_xor(s1, o); s2 += __shfl_xor(s2, o); }
      if (tid == 0) ((float*)(p.ws + WS_MISC))[0] = __expf(s1) - __expf(s2) + LAMBDA_INIT;
    }
  }
}

__device__ __forceinline__ void phase_h0(const P& p) {
  const float* mod = (const float*)(p.ws + WS_MOD);
  bf16_t* hb = (bf16_t*)(p.ws + WS_ABUF);
  const size_t total = (size_t)NROW * 128;
  int tid = threadIdx.x; LAUNDER_V(tid);
  for (size_t i = (size_t)blockIdx.x * NTHR + tid; i < total; i += (size_t)gridDim.x * NTHR) {
    const int row = (int)(i >> 7), c8 = (int)(i & 127) * 8;
    const int b = row / TPB, t = row % TPB;
    const float* src; int v;
    if (t < SEQ) { src = p.x + ((size_t)b * SEQ + t) * 1024; v = b; } else { src = p.ctx + ((size_t)b * CTXL + (t - SEQ)) * 1024; v = 2; }
    const float* sh = mod + v * 3072 + c8; const float* sc = sh + 1024;
    const f32x4 x0 = *(const f32x4*)(src + c8), x1 = *(const f32x4*)(src + c8 + 4);
    const f32x4 s0 = *(const f32x4*)sc, s1 = *(const f32x4*)(sc + 4), h0 = *(const f32x4*)sh, h1 = *(const f32x4*)(sh + 4);
    u32x4 w;
    w.x = cvtpk(x0[0] * (1.f + s0[0]) + h0[0], x0[1] * (1.f + s0[1]) + h0[1]);
    w.y = cvtpk(x0[2] * (1.f + s0[2]) + h0[2], x0[3] * (1.f + s0[3]) + h0[3]);
    w.z = cvtpk(x1[0] * (1.f + s1[0]) + h1[0], x1[1] * (1.f + s1[1]) + h1[1]);
    w.w = cvtpk(x1[2] * (1.f + s1[2]) + h1[2], x1[3] * (1.f + s1[3]) + h1[3]);
    *(u32x4*)(hb + (size_t)row * 1024 + c8) = w;
  }
}

template <int MB, class Epi>
__device__ __forceinline__ void gemm_tile(const bf16_t* __restrict__ A, int lda, const bf16_t* __restrict__ Bt, int ldb, int K, const Epi& epi, char* lds) {
  int tid = threadIdx.x; LAUNDER_V(tid);
  const int wid = tid >> 6, lane = tid & 63, r32 = lane & 31, hi = lane >> 5;
  const int m0 = (wid >> 2) * (MB * 32), n0 = (wid & 3) * 64;
  const int sc = tid & 7, sr = tid >> 3;
  const unsigned aofs = (unsigned)(sr * lda + sc * 8) * 2u, bofs = (unsigned)(sr * ldb + sc * 8) * 2u;
  const int sw = sr * 128 + ((sc ^ ((sr >> 1) & 7)) << 4);
  const int xr = (r32 >> 1) & 7;
  const int aoff = (m0 + r32) * 128, boff = 32768 + (n0 + r32) * 128;
  const int co0 = ((0 + hi) ^ xr) << 4, co1 = ((2 + hi) ^ xr) << 4, co2 = ((4 + hi) ^ xr) << 4, co3 = ((6 + hi) ^ xr) << 4;
  f32x16 acc[MB][2];
#pragma unroll
  for (int i = 0; i < MB; ++i) { acc[i][0] = f32x16{}; acc[i][1] = f32x16{}; }
  u32x4 ra[MB], rb[4];
  const int nk = K >> 6;
#define GLOAD(kt) do { const char* ab_ = (const char*)A + (size_t)(kt) * 128; const char* bb_ = (const char*)Bt + (size_t)(kt) * 128; \
    _Pragma("unroll") for (int i = 0; i < MB; ++i) ra[i] = *(const u32x4*)(ab_ + (size_t)(i * 64) * lda * 2 + aofs); \
    _Pragma("unroll") for (int i = 0; i < 4; ++i) rb[i] = *(const u32x4*)(bb_ + (size_t)(i * 64) * ldb * 2 + bofs); } while (0)
#define GWRITE(buf) do { _Pragma("unroll") for (int i = 0; i < MB; ++i) *(u32x4*)(lds + (buf) * 65536 + sw + i * 8192) = ra[i]; \
    _Pragma("unroll") for (int i = 0; i < 4; ++i) *(u32x4*)(lds + (buf) * 65536 + 32768 + sw + i * 8192) = rb[i]; } while (0)
#define FLOAD(fa, fb, co) do { _Pragma("unroll") for (int mb = 0; mb < MB; ++mb) fa[mb] = *(const bf16x8*)(base + aoff + mb * 4096 + (co)); \
    _Pragma("unroll") for (int nb = 0; nb < 2; ++nb) fb[nb] = *(const bf16x8*)(base + boff + nb * 4096 + (co)); } while (0)
#define FMMA(fa, fb) do { _Pragma("unroll") for (int mb = 0; mb < MB; ++mb) _Pragma("unroll") for (int nb = 0; nb < 2; ++nb) \
    acc[mb][nb] = __builtin_amdgcn_mfma_f32_32x32x16_bf16(fa[mb], fb[nb], acc[mb][nb], 0, 0, 0); } while (0)
  GLOAD(0); GWRITE(0); if (nk > 1) GLOAD(1); __syncthreads();
  for (int kt = 0; kt < nk; ++kt) {
    const int buf = kt & 1;
    const char* base = lds + buf * 65536;
    bf16x8 a0[MB], b0[2], a1[MB], b1[2];
    FLOAD(a0, b0, co0); SBAR();
    if (kt + 1 < nk) { GWRITE(buf ^ 1); if (kt + 2 < nk) GLOAD(kt + 2); } SBAR();
    FLOAD(a1, b1, co1); FMMA(a0, b0); SBAR();
    FLOAD(a0, b0, co2); FMMA(a1, b1); SBAR();
    FLOAD(a1, b1, co3); FMMA(a0, b0); SBAR();
    FMMA(a1, b1); SBAR();
    __syncthreads();
  }
#undef GLOAD
#undef GWRITE
#undef FLOAD
#undef FMMA
  epi.template operator()<MB>(acc, m0, n0, r32, hi);
}

struct EpiBf16 {
  bf16_t* O; int ldo; const float* rs;
  template <int MB> __device__ __forceinline__ void operator()(const f32x16 (&acc)[MB][2], int m0, int n0, int r32, int hi) const {
    unsigned base = (unsigned)((m0 + 4 * hi) * ldo + n0 + r32) * 2u; LAUNDER_V(base);
    int rbase = m0 + 4 * hi; LAUNDER_V(rbase);
    char* Ob = (char*)O;
#pragma unroll
    for (int mb = 0; mb < MB; ++mb)
#pragma unroll
      for (int r = 0; r < 16; ++r) {
        const int rr = mb * 32 + (r & 3) + 8 * (r >> 2);
        const float s = rs ? rs[rbase + rr] : 1.f;
        const unsigned off = base + (unsigned)(rr * ldo) * 2u;
        *(bf16_t*)(Ob + off) = f2bf(acc[mb][0][r] * s);
        *(bf16_t*)(Ob + off + 64) = f2bf(acc[mb][1][r] * s);
        if ((r & 7) == 7) SBAR();
      }
  }
};
struct EpiOut {
  const float* res; float* out; const float* g;
  template <int MB> __device__ __forceinline__ void operator()(const f32x16 (&acc)[MB][2], int m0, int n0, int r32, int hi) const {
    const float g0 = g[n0 + r32], g1 = g[n0 + 32 + r32];
    unsigned base = (unsigned)((m0 + 4 * hi) * 1024 + n0 + r32) * 4u; LAUNDER_V(base);
    const char* rb = (const char*)res; char* ob = (char*)out;
#pragma unroll
    for (int mb = 0; mb < MB; ++mb)
#pragma unroll
      for (int r = 0; r < 16; ++r) {
        const unsigned off = base + (unsigned)((mb * 32 + (r & 3) + 8 * (r >> 2)) * 4096);
        const float x0 = *(const float*)(rb + off), x1 = *(const float*)(rb + off + 128);
        *(float*)(ob + off) = ALPHA * x0 + g0 * acc[mb][0][r];
        *(float*)(ob + off + 128) = ALPHA * x1 + g1 * acc[mb][1][r];
        if ((r & 3) == 3) SBAR();
      }
  }
};

namespace g8 {
constexpr int BK = 64, HALF = 128, HT = HALF * BK;
__device__ __forceinline__ int lds_byte(int r, int c) { const int st = (r >> 4) * 2 + (c >> 5), rr = r & 15, cc = c & 31, ob = rr * 64 + cc * 2; return st * 1024 + (ob ^ (((ob >> 9) & 1) << 5)); }
__device__ __forceinline__ void stage_rc(int b, int& R, int& C) { const int st = b / 1024, sb = b % 1024, swz = sb ^ (((sb >> 9) & 1) << 5); R = (st >> 1) * 16 + swz / 64; C = (st & 1) * 32 + (swz % 64) / 2; }
template <class Epi>
__device__ __forceinline__ void gemm_tile8(const bf16_t* __restrict__ A, const bf16_t* __restrict__ Bt, int K, const Epi& epi, char* lds) {
  bf16_t* shm = (bf16_t*)lds;
  int tid = threadIdx.x; LAUNDER_V(tid);
#define SA(b, h) (shm + ((b) * 2 + (h)) * HT)
#define SB(b, h) (shm + (4 + (b) * 2 + (h)) * HT)
#define STAGE(Pp, BASE, br, kt) do { const long g_ = (long)(br) * K + (long)(kt) * BK; \
    _Pragma("unroll") for (int i_ = 0; i_ < 2; ++i_) { const int b_ = tid * 16 + i_ * 8192; int r_, c_; stage_rc(b_, r_, c_); \
      __builtin_amdgcn_global_load_lds((const unsigned*)(BASE + g_ + (long)r_ * K + c_), (unsigned*)((char*)(Pp) + b_), 16, 0, 0); } } while (0)
#define LDA(dst, b, h) _Pragma("unroll") for (int m = 0; m < 4; ++m) _Pragma("unroll") for (int k = 0; k < 2; ++k) \
    dst[m][k] = *reinterpret_cast<const bf16x8*>((char*)SA(b, h) + lds_byte(wr * 64 + m * 16 + fr, k * 32 + fq * 8))
#define LDB(dst, b, h) _Pragma("unroll") for (int n = 0; n < 2; ++n) _Pragma("unroll") for (int k = 0; k < 2; ++k) \
    dst[n][k] = *reinterpret_cast<const bf16x8*>((char*)SB(b, h) + lds_byte(wc * 32 + n * 16 + fr, k * 32 + fq * 8))
#define MMA(ai, bj, Af, Bf) do { __builtin_amdgcn_s_setprio(1); \
    _Pragma("unroll") for (int m = 0; m < 4; ++m) _Pragma("unroll") for (int n = 0; n < 2; ++n) _Pragma("unroll") for (int k = 0; k < 2; ++k) \
      acc[ai][bj][m][n] = __builtin_amdgcn_mfma_f32_16x16x32_bf16(Bf[n][k], Af[m][k], acc[ai][bj][m][n], 0, 0, 0); \
    __builtin_amdgcn_s_setprio(0); } while (0)
#define WAIT_V(n) asm volatile("s_waitcnt vmcnt(" #n ")" ::: "memory")
#define WAIT_L(n) asm volatile("s_waitcnt lgkmcnt(" #n ")" ::: "memory")
#define BAR __builtin_amdgcn_s_barrier()
#define SCHED __builtin_amdgcn_sched_barrier(0)
  const int wid = tid >> 6, lane = tid & 63, wr = wid >> 2, wc = wid & 3, fr = lane & 15, fq = lane >> 4;
  f32x4 acc[2][2][4][2];
#pragma unroll
  for (int a_ = 0; a_ < 2; ++a_)
#pragma unroll
    for (int b_ = 0; b_ < 2; ++b_)
#pragma unroll
      for (int m = 0; m < 4; ++m) { acc[a_][b_][m][0] = f32x4{0.f, 0.f, 0.f, 0.f}; acc[a_][b_][m][1] = f32x4{0.f, 0.f, 0.f, 0.f}; }
  bf16x8 At[4][2], B0[2][2], B1[2][2];
  const int nt = K / BK;
  WAIT_V(0); __syncthreads();
  STAGE(SB(0, 0), Bt, 0, 0); STAGE(SA(0, 0), A, 0, 0);
  STAGE(SB(0, 1), Bt, HALF, 0); STAGE(SA(0, 1), A, HALF, 0);
  if (wr == 1) BAR;
  WAIT_V(4); BAR;
  STAGE(SB(1, 0), Bt, 0, 1); STAGE(SA(1, 0), A, 0, 1); STAGE(SB(1, 1), Bt, HALF, 1);
  WAIT_V(6); BAR;
  for (int t = 0; t < nt - 2; t += 2) {
    LDB(B0, 0, 0); SCHED; LDA(At, 0, 0); STAGE(SA(1, 1), A, HALF, t + 1);
    WAIT_L(8); BAR; WAIT_L(0); MMA(0, 0, At, B0); BAR; SCHED;
    LDB(B1, 0, 1); STAGE(SB(0, 0), Bt, 0, t + 2);
    BAR; WAIT_L(0); MMA(0, 1, At, B1); BAR;
    LDA(At, 0, 1); STAGE(SA(0, 0), A, 0, t + 2);
    BAR; WAIT_L(0); MMA(1, 0, At, B0); BAR; SCHED;
    STAGE(SB(0, 1), Bt, HALF, t + 2);
    WAIT_V(6); BAR; MMA(1, 1, At, B1); BAR;
    LDB(B0, 1, 0); SCHED; LDA(At, 1, 0); STAGE(SA(0, 1), A, HALF, t + 2);
    WAIT_L(8); BAR; WAIT_L(0); MMA(0, 0, At, B0); BAR; SCHED;
    LDB(B1, 1, 1); STAGE(SB(1, 0), Bt, 0, t + 3);
    BAR; WAIT_L(0); MMA(0, 1, At, B1); BAR;
    LDA(At, 1, 1); STAGE(SA(1, 0), A, 0, t + 3);
    BAR; WAIT_L(0); MMA(1, 0, At, B0); BAR; SCHED;
    STAGE(SB(1, 1), Bt, HALF, t + 3);
    WAIT_V(6); BAR; MMA(1, 1, At, B1); BAR;
  }
  { LDB(B0, 0, 0); LDA(At, 0, 0); STAGE(SA(1, 1), A, HALF, nt - 1);
    BAR; WAIT_L(0); MMA(0, 0, At, B0); BAR;
    LDB(B1, 0, 1); BAR; WAIT_L(0); MMA(0, 1, At, B1); BAR;
    LDA(At, 0, 1); WAIT_V(4); BAR; WAIT_L(0); MMA(1, 0, At, B0); MMA(1, 1, At, B1); BAR; }
  { LDB(B0, 1, 0); LDA(At, 1, 0); WAIT_V(2); BAR; WAIT_L(0); MMA(0, 0, At, B0); BAR;
    LDB(B1, 1, 1); WAIT_V(0); BAR; WAIT_L(0); MMA(0, 1, At, B1); BAR;
    LDA(At, 1, 1); BAR; WAIT_L(0); MMA(1, 0, At, B0); MMA(1, 1, At, B1); BAR; }
  if (wr == 0) BAR;
#undef SA
#undef SB
#undef STAGE
#undef LDA
#undef LDB
#undef MMA
#undef WAIT_V
#undef WAIT_L
#undef BAR
#undef SCHED
  epi(acc, wr, wc, fr, fq);
}
struct EpiBf16 {
  bf16_t* O; int ldo;
  __device__ __forceinline__ void operator()(const f32x4 (&acc)[2][2][4][2], int wr, int wc, int fr, int fq) const {
    unsigned base = (unsigned)((wr * 64 + fr) * ldo + wc * 32 + fq * 4) * 2u; LAUNDER_V(base);
    char* Ob = (char*)O;
#pragma unroll
    for (int ai = 0; ai < 2; ++ai)
#pragma unroll
      for (int m = 0; m < 4; ++m) {
        const unsigned ro = base + (unsigned)((ai * 128 + m * 16) * ldo) * 2u;
#pragma unroll
        for (int bj = 0; bj < 2; ++bj)
#pragma unroll
          for (int n = 0; n < 2; ++n) {
            const f32x4 v = acc[ai][bj][m][n];
            u32x2 w; w.x = cvtpk(v[0], v[1]); w.y = cvtpk(v[2], v[3]);
            *(u32x2*)(Ob + ro + (bj * 128 + n * 16) * 2) = w;
          }
        SBAR();
      }
  }
};
struct EpiOut {
  const float* res; float* out; const float* g;
  __device__ __forceinline__ void operator()(const f32x4 (&acc)[2][2][4][2], int wr, int wc, int fr, int fq) const {
    unsigned base = (unsigned)((wr * 64 + fr) * 1024 + wc * 32 + fq * 4) * 4u; LAUNDER_V(base);
    const char* rb = (const char*)res; char* ob = (char*)out;
    f32x4 gv[2][2];
#pragma unroll
    for (int bj = 0; bj < 2; ++bj)
#pragma unroll
      for (int n = 0; n < 2; ++n) gv[bj][n] = *(const f32x4*)(g + bj * 128 + wc * 32 + n * 16 + fq * 4);
#pragma unroll
    for (int ai = 0; ai < 2; ++ai)
#pragma unroll
      for (int m = 0; m < 4; ++m) {
        const unsigned ro = base + (unsigned)((ai * 128 + m * 16) * 4096);
#pragma unroll
        for (int bj = 0; bj < 2; ++bj)
#pragma unroll
          for (int n = 0; n < 2; ++n) {
            const unsigned o_ = ro + (bj * 128 + n * 16) * 4;
            const f32x4 x = *(const f32x4*)(rb + o_);
            *(f32x4*)(ob + o_) = x * ALPHA + gv[bj][n] * acc[ai][bj][m][n];
          }
        SBAR();
      }
  }
};
}

__device__ __forceinline__ void tile_order(int L, int nM, int nN, int& pm, int& pn) {
  const int nwg = nM * nN, q = nwg >> 3, r = nwg & 7, xcd = L & 7, off = L >> 3;
  const int wgid = (xcd < r ? xcd * (q + 1) : r * (q + 1) + (xcd - r) * q) + off;
  const int nig = 8 * nN, gid = wgid / nig, fm = gid * 8, gsz = (nM - fm) < 8 ? (nM - fm) : 8;
  pm = fm + ((wgid % nig) % gsz); pn = (wgid % nig) / gsz;
}
__device__ __forceinline__ void phase_gemm1(const P& p, int layer, char* lds) {
  const int npad = layer == 0 ? NPAD0 : layer == 1 ? NPAD1 : layer == 2 ? NPAD2 : NPAD3;
  const size_t woff = layer == 0 ? WS_WIN0 : layer == 1 ? WS_WIN1 : layer == 2 ? WS_WIN2 : WS_WIN3;
  const bf16_t* A = (const bf16_t*)(p.ws + WS_ABUF);
  const bf16_t* W = (const bf16_t*)(p.ws + woff);
  bf16_t* O = (bf16_t*)(p.ws + WS_PROJ);
  const int nN = npad / 256, nt = 128 * nN;
  for (int t = blockIdx.x; t < nt; t += gridDim.x) {
    int pl, pn; tile_order(t, 128, nN, pl, pn); const int pm = pl + pl / 64;
    g8::EpiBf16 e{O + (size_t)pm * 256 * npad + pn * 256, npad};
    g8::gemm_tile8(A + (size_t)pm * 256 * 1024, W + (size_t)pn * 256 * 1024, 1024, e, lds);
  }
  for (int u = gridDim.x - 1 - blockIdx.x; u < 8 * nN; u += gridDim.x) {
    const int q = u / nN, pn = u % nN; const size_t row0 = (size_t)(q >> 2) * TPB + SEQ + (q & 3) * 64;
    EpiBf16 e{O + row0 * npad + pn * 256, npad, nullptr};
    gemm_tile<1>(A + row0 * 1024, 1024, W + (size_t)pn * 256 * 1024, 1024, 1024, e, lds);
  }
}

__device__ __forceinline__ void phase_gemm2(const P& p, char* lds) {
  const bf16_t* P1 = (const bf16_t*)(p.ws + WS_PROJ);
  float* rs = (float*)(lds + 131072);
  int tid = threadIdx.x; LAUNDER_V(tid);
  for (int t = blockIdx.x; t < 130 * 14; t += gridDim.x) {
    const int pm = t / 14, j = t % 14;
    const bool isq = j < 6; const int pn = isq ? j : j - 6;
    const int KK = isq ? 256 : 128, acol = isq ? 0 : 256;
    const bf16_t* A = P1 + (size_t)pm * 256 * 1536 + acol;
    {
      const int r = tid >> 1, half = tid & 1;
      const bf16_t* ap = A + (size_t)r * 1536 + half * (KK / 2);
      float ss = 0.f;
      for (int i = 0; i < KK / 16; ++i) { const bf16x8 v = *(const bf16x8*)(ap + i * 8);
#pragma unroll
        for (int e = 0; e < 8; ++e) { const float f = bf2f(v[e]); ss += f * f; } }
      ss += __shfl_xor(ss, 1);
      if (!half) rs[r] = rsqrtf(ss / (float)KK + EPS);
    }
    __syncthreads();
    if (isq) {
      EpiBf16 e{(bf16_t*)(p.ws + WS_X) + (size_t)pm * 256 * 1536 + pn * 256, 1536, rs};
      gemm_tile<4>(A, 1536, (const bf16_t*)(p.ws + WS_WQB) + (size_t)pn * 256 * 256, 256, 256, e, lds);
    } else {
      EpiBf16 e{(bf16_t*)(p.ws + WS_KV2) + (size_t)pm * 256 * 2048 + pn * 256, 2048, rs};
      gemm_tile<4>(A, 1536, (const bf16_t*)(p.ws + WS_WKVB) + (size_t)pn * 256 * 128, 128, 128, e, lds);
    }
    __syncthreads();
  }
}

__device__ __forceinline__ void phase_outproj(const P& p, int layer, char* lds) {
  const bf16_t* A = (const bf16_t*)(p.ws + WS_ABUF);
  const bf16_t* W = (const bf16_t*)(p.ws + WS_WOUT) + (size_t)layer * 1024 * 1024;
  float* X = (float*)(p.ws + WS_X);
  const float* mod = (const float*)(p.ws + WS_MOD) + layer * 3 * 3072;
  for (int t = blockIdx.x; t < 128 * 4; t += gridDim.x) {
    int pl, pn; tile_order(t, 128, 4, pl, pn); const int pm = pl + pl / 64; const int b = pm / 65, lt = pm % 65;
    const float* res = layer == 0 ? p.x + ((size_t)b * SEQ + lt * 256) * 1024 : X + (size_t)pm * 256 * 1024;
    g8::EpiOut e{res + pn * 256, X + (size_t)pm * 256 * 1024 + pn * 256, mod + b * 3072 + 2048 + pn * 256};
    g8::gemm_tile8(A + (size_t)pm * 256 * 1024, W + (size_t)pn * 256 * 1024, 1024, e, lds);
  }
  if (layer < 3) {
    for (int u = blockIdx.x; u < 32; u += gridDim.x) {
      const int q = u >> 2, pn = u & 3; const int b = q >> 2; const size_t row0 = (size_t)b * TPB + SEQ + (q & 3) * 64;
      const float* res = layer == 0 ? p.ctx + ((size_t)b * CTXL + (q & 3) * 64) * 1024 : X + row0 * 1024;
      EpiOut e{res + pn * 256, X + row0 * 1024 + pn * 256, mod + 2 * 3072 + 2048 + pn * 256};
      gemm_tile<1>(A + row0 * 1024, 1024, W + (size_t)pn * 256 * 1024, 1024, 1024, e, lds);
    }
  }
}

__device__ __forceinline__ void phase_ln(const P& p, int layer) {
  float* X = (float*)(p.ws + WS_X);
  bf16_t* hb = (bf16_t*)(p.ws + WS_ABUF);
  const float* g = p.ln_g + layer * 1024; const float* bb = p.ln_b + layer * 1024;
  const float* modn = (const float*)(p.ws + WS_MOD) + (layer + 1) * 3 * 3072;
  const bool last = layer == 3;
  int tid = threadIdx.x; LAUNDER_V(tid);
  const int wid = tid >> 6, lane = tid & 63;
  for (int row = blockIdx.x * 8 + wid; row < NROW; row += gridDim.x * 8) {
    const int b = row / TPB, t = row % TPB;
    if (last && t >= SEQ) continue;
    float* xr = X + (size_t)row * 1024;
    f32x4 v[4]; float s = 0.f;
#pragma unroll
    for (int j = 0; j < 4; ++j) { v[j] = *(const f32x4*)(xr + j * 256 + lane * 4); s += (v[j][0] + v[j][1]) + (v[j][2] + v[j][3]); }
#pragma unroll
    for (int o = 32; o >= 1; o >>= 1) s += __shfl_xor(s, o);
    const float mean = s * (1.f / 1024.f); float q = 0.f;
#pragma unroll
    for (int j = 0; j < 4; ++j) { v[j] = v[j] - mean; q += (v[j][0] * v[j][0] + v[j][1] * v[j][1]) + (v[j][2] * v[j][2] + v[j][3] * v[j][3]); }
#pragma unroll
    for (int o = 32; o >= 1; o >>= 1) q += __shfl_xor(q, o);
    const float rstd = rsqrtf(q * (1.f / 1024.f) + EPS);
    const int vsel = t < SEQ ? b : 2;
    float* dst = last ? p.out + ((size_t)b * SEQ + t) * 1024 : xr;
#pragma unroll
    for (int j = 0; j < 4; ++j) {
      const int col = j * 256 + lane * 4;
      const f32x4 gg = *(const f32x4*)(g + col), be = *(const f32x4*)(bb + col);
      f32x4 y = v[j] * rstd * gg + be;
      *(f32x4*)(dst + col) = y;
      if (!last) {
        const f32x4 sh = *(const f32x4*)(modn + vsel * 3072 + col), sc = *(const f32x4*)(modn + vsel * 3072 + 1024 + col);
        u32x2 w; w.x = cvtpk(y[0] * (1.f + sc[0]) + sh[0], y[1] * (1.f + sc[1]) + sh[1]); w.y = cvtpk(y[2] * (1.f + sc[2]) + sh[2], y[3] * (1.f + sc[3]) + sh[3]);
        *(u32x2*)(hb + (size_t)row * 1024 + col) = w;
      }
    }
  }
}

__device__ __forceinline__ void unpack8(bf16x8 v, float (&f)[8]) {
#pragma unroll
  for (int e = 0; e < 8; ++e) f[e] = bf2f(v[e]);
}
__device__ __forceinline__ bf16x8 pack8(const float (&f)[8]) {
  u32x4 w = {cvtpk(f[0], f[1]), cvtpk(f[2], f[3]), cvtpk(f[4], f[5]), cvtpk(f[6], f[7])}; return *reinterpret_cast<bf16x8*>(&w);
}
__device__ __forceinline__ void rope8f(float (&x1)[8], float (&x2)[8], const float* cs, const float* sn) {
  const f32x4 c0 = *(const f32x4*)cs, c1 = *(const f32x4*)(cs + 4), s0 = *(const f32x4*)sn, s1 = *(const f32x4*)(sn + 4);
#pragma unroll
  for (int e = 0; e < 8; ++e) {
    const float c = e < 4 ? c0[e & 3] : c1[e & 3], s = e < 4 ? s0[e & 3] : s1[e & 3];
    const float a = x1[e], b = x2[e];
    x1[e] = a * c - b * s; x2[e] = b * c + a * s;
  }
}
__device__ __forceinline__ void rope8(bf16x8& a, bf16x8& b, const float* cs, const float* sn) {
  float x1[8], x2[8]; unpack8(a, x1); unpack8(b, x2); rope8f(x1, x2, cs, sn); a = pack8(x1); b = pack8(x2);
}

template <int KIND>
__device__ __forceinline__ void phase_kfix(const P& p) {
  constexpr int HD = KIND == 0 ? 32 : KIND == 2 ? 128 : 64;
  constexpr int UPR = KIND == 0 ? 1 : KIND == 1 ? 16 : 2;
  constexpr int G = HD / 16, NF = HD / 4;
  constexpr int LD = KIND == 0 ? NPAD0 : KIND == 1 ? NPAD1 : KIND == 2 ? NPAD2 : NPAD3;
  constexpr int BASE = KIND == 0 ? 384 : 1024;
  constexpr int ROFF = KIND == 0 ? ROPE32_OFF : KIND == 2 ? ROPE128_OFF : ROPE64_OFF;
  bf16_t* proj = (bf16_t*)(p.ws + WS_PROJ);
  const float* rt = (const float*)(p.ws + WS_ROPE) + ROFF;
  const size_t total = (size_t)NROW * UPR * G;
  int tid = threadIdx.x; LAUNDER_V(tid);
  for (size_t i = (size_t)blockIdx.x * NTHR + tid; i < total; i += (size_t)gridDim.x * NTHR) {
    const int sub = (int)(i % G); const size_t u = i / G; const int head = (int)(u % UPR); const int row = (int)(u / UPR);
    const int t = row % TPB; const bool latent = t < SEQ;
    if (KIND != 2 && !latent) continue;
    bf16_t* ptr = proj + (size_t)row * LD + BASE + head * HD + sub * 8;
    float x1[8], x2[8];
    unpack8(*(const bf16x8*)ptr, x1); unpack8(*(const bf16x8*)(ptr + HD / 2), x2);
    if (KIND == 2) {
      float ss = 0.f;
#pragma unroll
      for (int e = 0; e < 8; ++e) ss += x1[e] * x1[e] + x2[e] * x2[e];
      ss += __shfl_xor(ss, 1); ss += __shfl_xor(ss, 2); ss += __shfl_xor(ss, 4);
      const float rstd = rsqrtf(ss * (1.f / 128.f) + EPS);
#pragma unroll
      for (int e = 0; e < 8; ++e) { x1[e] *= rstd * p.gqa_g_k[sub * 8 + e]; x2[e] *= rstd * p.gqa_g_k[64 + sub * 8 + e]; }
    }
    if (latent) {
      const bool isrow = sub * 8 < NF; const int f0 = isrow ? sub * 8 : sub * 8 - NF; const int pos = isrow ? (t >> 6) : (t & 63);
      rope8f(x1, x2, rt + pos * NF + f0, rt + 256 * NF + pos * NF + f0);
    }
    *(bf16x8*)ptr = pack8(x1); *(bf16x8*)(ptr + HD / 2) = pack8(x2);
  }
}

template <int NCB> __device__ __forceinline__ int v_st(int k, int c) { const int kk = k;     return ((kk >> 3) * NCB + (c >> 5)) * 512 + ((kk & 7) * 32 + (c & 31)) * 2; }
__device__ __forceinline__ int v_rd_base(int lane) { return ((lane & 3) << 3) | (((lane >> 2) & 3) << 6) | (((lane >> 4) & 1) << 5) | (((lane >> 5) & 1) << 8); }
template <int OFF> __device__ __forceinline__ s16x4 tr_read(int vb) {
  s16x4 r; asm volatile("ds_read_b64_tr_b16 %0, %1 offset:%2" : "=&v"(r) : "v"(vb), "i"(OFF) : "memory"); return r;
}
template <int NCB, int D0> __device__ __forceinline__ void pv_one(f32x16& od, int vb, bf16x8 pa0, bf16x8 pa1, bf16x8 pa2, bf16x8 pa3) {
#define VOFF(ks, half) (((2 * (ks) + (half)) * NCB + D0) * 512)
  const s16x4 l0 = tr_read<VOFF(0, 0)>(vb), h0 = tr_read<VOFF(0, 1)>(vb), l1 = tr_read<VOFF(1, 0)>(vb), h1 = tr_read<VOFF(1, 1)>(vb);
  const s16x4 l2 = tr_read<VOFF(2, 0)>(vb), h2 = tr_read<VOFF(2, 1)>(vb), l3 = tr_read<VOFF(3, 0)>(vb), h3 = tr_read<VOFF(3, 1)>(vb);
#undef VOFF
  asm volatile("s_waitcnt lgkmcnt(0)" ::: "memory"); SBAR();
#define PK(L, H) (bf16x8){L[0], L[1], L[2], L[3], H[0], H[1], H[2], H[3]}
  od = __builtin_amdgcn_mfma_f32_32x32x16_bf16(pa0, PK(l0, h0), od, 0, 0, 0);
  od = __builtin_amdgcn_mfma_f32_32x32x16_bf16(pa1, PK(l1, h1), od, 0, 0, 0);
  od = __builtin_amdgcn_mfma_f32_32x32x16_bf16(pa2, PK(l2, h2), od, 0, 0, 0);
  od = __builtin_amdgcn_mfma_f32_32x32x16_bf16(pa3, PK(l3, h3), od, 0, 0, 0);
#undef PK
}
template <int NCB, int KS> __device__ __forceinline__ void v_reads_ks(s16x4 (&v)[8], int vb) {
#define VOFF(d, half) (((2 * KS + (half)) * NCB + (d)) * 512)
  v[0] = tr_read<VOFF(0, 0)>(vb); v[1] = tr_read<VOFF(0, 1)>(vb); v[2] = tr_read<VOFF(1, 0)>(vb); v[3] = tr_read<VOFF(1, 1)>(vb);
  v[4] = tr_read<VOFF(2, 0)>(vb); v[5] = tr_read<VOFF(2, 1)>(vb); v[6] = tr_read<VOFF(3, 0)>(vb); v[7] = tr_read<VOFF(3, 1)>(vb);
#undef VOFF
}
__device__ __forceinline__ void pv_mm_ks(f32x16 (&o)[4], const s16x4 (&v)[8], bf16x8 pa) {
#define PK(L, H) (bf16x8){L[0], L[1], L[2], L[3], H[0], H[1], H[2], H[3]}
  o[0] = __builtin_amdgcn_mfma_f32_32x32x16_bf16(pa, PK(v[0], v[1]), o[0], 0, 0, 0);
  o[1] = __builtin_amdgcn_mfma_f32_32x32x16_bf16(pa, PK(v[2], v[3]), o[1], 0, 0, 0);
  o[2] = __builtin_amdgcn_mfma_f32_32x32x16_bf16(pa, PK(v[4], v[5]), o[2], 0, 0, 0);
  o[3] = __builtin_amdgcn_mfma_f32_32x32x16_bf16(pa, PK(v[6], v[7]), o[3], 0, 0, 0);
#undef PK
}
template <int NCB> __device__ __forceinline__ void pv_all(f32x16 (&o)[NCB], int vb, bf16x8 pa0, bf16x8 pa1, bf16x8 pa2, bf16x8 pa3) {
  if constexpr (NCB == 4) {
    s16x4 va[8], vc[8];
    v_reads_ks<4, 0>(va, vb);
    v_reads_ks<4, 1>(vc, vb); asm volatile("s_waitcnt lgkmcnt(8)" ::: "memory"); SBAR(); pv_mm_ks(o, va, pa0);
    v_reads_ks<4, 2>(va, vb); asm volatile("s_waitcnt lgkmcnt(8)" ::: "memory"); SBAR(); pv_mm_ks(o, vc, pa1);
    v_reads_ks<4, 3>(vc, vb); asm volatile("s_waitcnt lgkmcnt(8)" ::: "memory"); SBAR(); pv_mm_ks(o, va, pa2);
    asm volatile("s_waitcnt lgkmcnt(0)" ::: "memory"); SBAR(); pv_mm_ks(o, vc, pa3);
  } else {
    pv_one<NCB, 0>(o[0], vb, pa0, pa1, pa2, pa3); pv_one<NCB, 1>(o[1], vb, pa0, pa1, pa2, pa3);
  }
}

constexpr float THR = 8.f;
template <int DQK> struct ScaleOf { static constexpr float v = DQK == 64 ? 0.125f : DQK == 96 ? 0.10206207261596575f : 0.08838834764831845f; };

template <int DQK>
__device__ __forceinline__ void partialSM(f32x16& p0, f32x16& p1, float& m_reg, float& mn, float& alpha) {
  constexpr float SCALE = ScaleOf<DQK>::v, C = SCALE * LOG2E;
  float pmax = p0[0];
#pragma unroll
  for (int r = 1; r < 16; ++r) pmax = fmaxf(pmax, p0[r]);
#pragma unroll
  for (int r = 0; r < 16; ++r) pmax = fmaxf(pmax, p1[r]);
  { auto rr = __builtin_amdgcn_permlane32_swap(__float_as_uint(pmax), __float_as_uint(pmax), false, false);
    pmax = fmaxf(__uint_as_float(rr[0]), __uint_as_float(rr[1])); }
  if (__builtin_expect(__all(pmax - m_reg <= THR / SCALE), 1)) { mn = m_reg; alpha = 1.f; }
  else { mn = fmaxf(m_reg, pmax); alpha = __builtin_amdgcn_exp2f((m_reg - mn) * C); m_reg = mn; }
  const float mnC = -mn * C;
#pragma unroll
  for (int r = 0; r < 16; ++r) p0[r] = fmaf(p0[r], C, mnC);
#pragma unroll
  for (int r = 0; r < 16; ++r) p1[r] = fmaf(p1[r], C, mnC);
#pragma unroll
  for (int r = 0; r < 16; ++r) p0[r] = __builtin_amdgcn_exp2f(p0[r]);
}
__device__ __forceinline__ void finishSM(f32x16& p0, f32x16& p1, float alpha, float& l_reg, bf16x8& pa0, bf16x8& pa1, bf16x8& pa2, bf16x8& pa3) {
#pragma unroll
  for (int r = 0; r < 16; ++r) p1[r] = __builtin_amdgcn_exp2f(p1[r]);
  float ps = 0;
#pragma unroll
  for (int r = 0; r < 16; ++r) ps += p0[r];
#pragma unroll
  for (int r = 0; r < 16; ++r) ps += p1[r];
  { auto rr = __builtin_amdgcn_permlane32_swap(__float_as_uint(ps), __float_as_uint(ps), false, false);
    ps = __uint_as_float(rr[0]) + __uint_as_float(rr[1]); }
  l_reg = l_reg * alpha + ps;
#define PK4(Pv, BASE, OUT) do { unsigned a0 = cvtpk(Pv[BASE + 0], Pv[BASE + 1]), a1 = cvtpk(Pv[BASE + 2], Pv[BASE + 3]);   \
    unsigned b0 = cvtpk(Pv[BASE + 4], Pv[BASE + 5]), b1 = cvtpk(Pv[BASE + 6], Pv[BASE + 7]);                              \
    auto r0 = __builtin_amdgcn_permlane32_swap(a0, b0, false, false); auto r1 = __builtin_amdgcn_permlane32_swap(a1, b1, false, false); \
    u32x4 w = {r0[0], r1[0], r0[1], r1[1]}; OUT = *reinterpret_cast<bf16x8*>(&w); } while (0)
  PK4(p0, 0, pa0); PK4(p0, 8, pa1); PK4(p1, 0, pa2); PK4(p1, 8, pa3);
#undef PK4
}
template <int DQK>
__device__ __forceinline__ void qkt(f32x16& p0, f32x16& p1, const char* Ks, const bf16x8 (&qr)[DQK / 16], int r32, int hi) {
  constexpr int KSTR = DQK * 2 + 16;
  p0 = f32x16{}; p1 = f32x16{};
#pragma unroll
  for (int d0 = 0; d0 < DQK / 16; ++d0) { const int cb = (d0 * 16 + hi * 8) * 2;
    const bf16x8 b0 = *reinterpret_cast<const bf16x8*>(Ks + r32 * KSTR + cb);
    const bf16x8 b1 = *reinterpret_cast<const bf16x8*>(Ks + (32 + r32) * KSTR + cb);
    p0 = __builtin_amdgcn_mfma_f32_32x32x16_bf16(b0, qr[d0], p0, 0, 0, 0);
    p1 = __builtin_amdgcn_mfma_f32_32x32x16_bf16(b1, qr[d0], p1, 0, 0, 0); }
}
__device__ __forceinline__ void swa_mask(f32x16& p0, f32x16& p1, int kp0, int qpos, int hi) {
  const float ninf = -__builtin_inff();
#pragma unroll
  for (int r = 0; r < 16; ++r) {
    const int d0 = kp0 + crow(r, hi) - qpos, d1 = d0 + 32;
    if (d0 > 128 || d0 < -128) p0[r] = ninf;
    if (d1 > 128 || d1 < -128) p1[r] = ninf;
  }
}

template <int OFF> __device__ __forceinline__ bf16x8 lds_rd128(int a) {
  bf16x8 r; asm volatile("ds_read_b128 %0, %1 offset:%2" : "=&v"(r) : "v"(a), "i"(OFF) : "memory"); return r;
}
#define WAITL(n) do { asm volatile("s_waitcnt lgkmcnt(" #n ")" ::: "memory"); SBAR(); } while (0)
template <int NCB, int D0> __device__ __forceinline__ void v_reads(s16x4 (&v)[8], int vb) {
#define VOFF(ks, half) (((2 * (ks) + (half)) * NCB + D0) * 512)
  v[0] = tr_read<VOFF(0, 0)>(vb); v[1] = tr_read<VOFF(0, 1)>(vb); v[2] = tr_read<VOFF(1, 0)>(vb); v[3] = tr_read<VOFF(1, 1)>(vb);
  v[4] = tr_read<VOFF(2, 0)>(vb); v[5] = tr_read<VOFF(2, 1)>(vb); v[6] = tr_read<VOFF(3, 0)>(vb); v[7] = tr_read<VOFF(3, 1)>(vb);
#undef VOFF
}
__device__ __forceinline__ void pv_mm(f32x16& od, const s16x4 (&v)[8], bf16x8 pa0, bf16x8 pa1, bf16x8 pa2, bf16x8 pa3) {
#define PK(L, H) (bf16x8){L[0], L[1], L[2], L[3], H[0], H[1], H[2], H[3]}
  od = __builtin_amdgcn_mfma_f32_32x32x16_bf16(pa0, PK(v[0], v[1]), od, 0, 0, 0);
  od = __builtin_amdgcn_mfma_f32_32x32x16_bf16(pa1, PK(v[2], v[3]), od, 0, 0, 0);
  od = __builtin_amdgcn_mfma_f32_32x32x16_bf16(pa2, PK(v[4], v[5]), od, 0, 0, 0);
  od = __builtin_amdgcn_mfma_f32_32x32x16_bf16(pa3, PK(v[6], v[7]), od, 0, 0, 0);
#undef PK
}
template <int DQK, int DV, bool DOQK>
__device__ __forceinline__ void mseg_body(f32x16& p0, f32x16& p1, f32x16 (&o)[DV / 32], const bf16x8 (&qr)[DQK / 16], int ka, int vb,
                                          bf16x8 pa0, bf16x8 pa1, bf16x8 pa2, bf16x8 pa3) {
  constexpr int NCB = DV / 32, KSTR = DQK * 2 + 16, R2 = 32 * KSTR;
  s16x4 va[8], vc[8];
#define QK2(KA, KB, D) do { p0 = __builtin_amdgcn_mfma_f32_32x32x16_bf16(KA, qr[D], p0, 0, 0, 0); p1 = __builtin_amdgcn_mfma_f32_32x32x16_bf16(KB, qr[D], p1, 0, 0, 0); } while (0)
  if constexpr (!DOQK) {
    v_reads<NCB, 0>(va, vb); v_reads<NCB, 1>(vc, vb);
  } else if constexpr (DQK == 64) {
    const bf16x8 k0 = lds_rd128<0>(ka), k1 = lds_rd128<R2>(ka), k2 = lds_rd128<32>(ka), k3 = lds_rd128<R2 + 32>(ka);
    const bf16x8 k4 = lds_rd128<64>(ka), k5 = lds_rd128<R2 + 64>(ka), k6 = lds_rd128<96>(ka), k7 = lds_rd128<R2 + 96>(ka);
    v_reads<NCB, 0>(va, vb); WAITL(8);
    v_reads<NCB, 1>(vc, vb);
    p0 = f32x16{}; p1 = f32x16{};
    QK2(k0, k1, 0); QK2(k2, k3, 1); QK2(k4, k5, 2); QK2(k6, k7, 3);
  } else if constexpr (DQK == 96) {
    const bf16x8 k0 = lds_rd128<0>(ka), k1 = lds_rd128<R2>(ka), k2 = lds_rd128<32>(ka), k3 = lds_rd128<R2 + 32>(ka), k4 = lds_rd128<64>(ka), k5 = lds_rd128<R2 + 64>(ka);
    const bf16x8 k6 = lds_rd128<96>(ka), k7 = lds_rd128<R2 + 96>(ka), k8 = lds_rd128<128>(ka), k9 = lds_rd128<R2 + 128>(ka), k10 = lds_rd128<160>(ka), k11 = lds_rd128<R2 + 160>(ka);
    WAITL(6);
    v_reads<NCB, 0>(va, vb);
    p0 = f32x16{}; p1 = f32x16{};
    QK2(k0, k1, 0); QK2(k2, k3, 1); QK2(k4, k5, 2);
    WAITL(8);
    v_reads<NCB, 1>(vc, vb);
    QK2(k6, k7, 3); QK2(k8, k9, 4); QK2(k10, k11, 5);
  } else {
    const bf16x8 k0 = lds_rd128<0>(ka), k1 = lds_rd128<R2>(ka), k2 = lds_rd128<32>(ka), k3 = lds_rd128<R2 + 32>(ka);
    const bf16x8 k4 = lds_rd128<64>(ka), k5 = lds_rd128<R2 + 64>(ka), k6 = lds_rd128<96>(ka), k7 = lds_rd128<R2 + 96>(ka);
    v_reads<NCB, 0>(va, vb); WAITL(8);
    p0 = f32x16{}; p1 = f32x16{};
    QK2(k0, k1, 0); QK2(k2, k3, 1); QK2(k4, k5, 2); QK2(k6, k7, 3);
    const bf16x8 j0 = lds_rd128<128>(ka), j1 = lds_rd128<R2 + 128>(ka), j2 = lds_rd128<160>(ka), j3 = lds_rd128<R2 + 160>(ka);
    const bf16x8 j4 = lds_rd128<192>(ka), j5 = lds_rd128<R2 + 192>(ka), j6 = lds_rd128<224>(ka), j7 = lds_rd128<R2 + 224>(ka);
    v_reads<NCB, 1>(vc, vb); WAITL(8);
    QK2(j0, j1, 4); QK2(j2, j3, 5); QK2(j4, j5, 6); QK2(j6, j7, 7);
  }
#undef QK2
  if constexpr (NCB == 4) {
    WAITL(8); pv_mm(o[0], va, pa0, pa1, pa2, pa3);
    v_reads<NCB, 2>(va, vb); WAITL(8); pv_mm(o[1], vc, pa0, pa1, pa2, pa3);
    v_reads<NCB, 3>(vc, vb); WAITL(8); pv_mm(o[2], va, pa0, pa1, pa2, pa3);
    WAITL(0); pv_mm(o[3], vc, pa0, pa1, pa2, pa3);
  } else {
    WAITL(8); pv_mm(o[0], va, pa0, pa1, pa2, pa3);
    WAITL(0); pv_mm(o[1], vc, pa0, pa1, pa2, pa3);
  }
}

template <int DQK, bool FAST>
__device__ __forceinline__ void softmax_tile(f32x16& p0, f32x16& p1, float& m_reg, float& l_reg, float& alpha, bf16x8& pa0, bf16x8& pa1, bf16x8& pa2, bf16x8& pa3) {
  constexpr float SCALE = ScaleOf<DQK>::v, C = SCALE * LOG2E;
  if constexpr (FAST) {
#pragma unroll
    for (int r = 0; r < 16; ++r) p0[r] = __builtin_amdgcn_exp2f(p0[r]);
#pragma unroll
    for (int r = 0; r < 16; ++r) p1[r] = __builtin_amdgcn_exp2f(p1[r]);
  } else {
  float pmax = p0[0];
#pragma unroll
  for (int r = 1; r < 16; ++r) pmax = fmaxf(pmax, p0[r]);
#pragma unroll
  for (int r = 0; r < 16; ++r) pmax = fmaxf(pmax, p1[r]);
  { auto rr = __builtin_amdgcn_permlane32_swap(__float_as_uint(pmax), __float_as_uint(pmax), false, false);
    pmax = fmaxf(__uint_as_float(rr[0]), __uint_as_float(rr[1])); }
  const bool any = __any((pmax - m_reg) > THR / SCALE);
  const float mn = any ? fmaxf(m_reg, pmax) : m_reg;
  alpha = __builtin_amdgcn_exp2f((m_reg - mn) * C);
  m_reg = mn;
  const float mnC = -mn * C;
#pragma unroll
  for (int r = 0; r < 16; ++r) p0[r] = __builtin_amdgcn_exp2f(fmaf(p0[r], C, mnC));
#pragma unroll
  for (int r = 0; r < 16; ++r) p1[r] = __builtin_amdgcn_exp2f(fmaf(p1[r], C, mnC));
  }
  float ps = 0;
#pragma unroll
  for (int r = 0; r < 16; ++r) ps += p0[r];
#pragma unroll
  for (int r = 0; r < 16; ++r) ps += p1[r];
  { auto rr = __builtin_amdgcn_permlane32_swap(__float_as_uint(ps), __float_as_uint(ps), false, false);
    ps = __uint_as_float(rr[0]) + __uint_as_float(rr[1]); }
  if constexpr (FAST) l_reg += ps; else l_reg = l_reg * alpha + ps;
#define PK4(Pv, BASE, OUT) do { u32x4 w = {cvtpk(Pv[BASE + 0], Pv[BASE + 1]), cvtpk(Pv[BASE + 2], Pv[BASE + 3]), cvtpk(Pv[BASE + 4], Pv[BASE + 5]), cvtpk(Pv[BASE + 6], Pv[BASE + 7])}; \
    OUT = *reinterpret_cast<bf16x8*>(&w); } while (0)
  PK4(p0, 0, pa0); PK4(p0, 8, pa1); PK4(p1, 0, pa2); PK4(p1, 8, pa3);
#undef PK4
}

template <int DQK, int DV, bool SWA, bool FAST>
__device__ __forceinline__ bool attn_core(f32x16 (&o)[DV / 32], const bf16x8 (&qr)[DQK / 16],
    const bf16_t* __restrict__ Kp, int ldk, const bf16_t* __restrict__ Kp2, int ldk2, const bf16_t* __restrict__ Vp, int ldv,
    int NT, int NL, int lo, int qpos, float sink_l2, char* lds) {
  constexpr int NCB = DV / 32, KSTR = DQK * 2 + 16, SHM_K = 64 * KSTR, SHM_V = 64 * DV * 2;
  constexpr int NKC = DQK == 64 ? 1 : 2, NVC = DV / 64;
  constexpr float SCALE = ScaleOf<DQK>::v, C = SCALE * LOG2E;
  int tid = threadIdx.x; LAUNDER_V(tid);
  const int wid = tid >> 6, lane = tid & 63, r32 = lane & 31, hi = lane >> 5;
  const bool grp1 = (wid & 4) != 0;
  char* V_lds = lds; char* K_lds = lds + 4 * SHM_V;
  float* wsf = (float*)(lds + 4 * SHM_V + 4 * SHM_K) + wid * 64; float* li_l = wsf; float* al_l = wsf + 32;
  float m_reg = -1e30f, l_reg = 0.f, alpha = 1.f;
#pragma unroll
  for (int d = 0; d < NCB; ++d) o[d] = f32x16{};
  unsigned ko[NKC]; int kl[NKC]; unsigned vo[NVC]; int vl[NVC];
  if constexpr (DQK == 128) {
#pragma unroll
    for (int i = 0; i < 2; ++i) { const int row = (tid >> 4) + 32 * i, c = tid & 15; ko[i] = (unsigned)(row * ldk + c * 8) * 2u; kl[i] = row * KSTR + c * 16; }
  } else if constexpr (DQK == 64) {
    const int row = tid >> 3, c = tid & 7; ko[0] = (unsigned)(row * ldk + c * 8) * 2u; kl[0] = row * KSTR + c * 16;
  } else {
    { const int row = tid >> 3, c = tid & 7; ko[0] = (unsigned)(row * ldk + c * 8) * 2u; kl[0] = row * KSTR + c * 16; }
    { const int t2 = tid & 255; const int row = t2 >> 2, c = t2 & 3; ko[1] = (unsigned)(row * ldk2 + c * 8) * 2u; kl[1] = row * KSTR + (8 + c) * 16; }
  }
  if constexpr (DV == 128) {
#pragma unroll
    for (int i = 0; i < 2; ++i) { const int row = (tid >> 4) + 32 * i, c = (tid & 15) * 8; vo[i] = (unsigned)(row * ldv + c) * 2u; vl[i] = v_st<NCB>(row, c); }
  } else {
    const int row = tid >> 3, c = (tid & 7) * 8; vo[0] = (unsigned)(row * ldv + c) * 2u; vl[0] = v_st<NCB>(row, c);
  }
  const int vb0 = (int)(uintptr_t)V_lds + v_rd_base(lane);
  const int ka0 = (int)(uintptr_t)K_lds + r32 * KSTR + hi * 16;
  bf16x8 sk[2][NKC], sv[2][NVC];
#define TROW(j) ((j) < NL ? lo + 64 * (j) : SEQ + 64 * ((j) - NL))
#define SLOAD(s, j) do { const size_t ro_ = (size_t)TROW(j); const char* kb_ = (const char*)Kp + ro_ * ldk * 2; const char* vb_ = (const char*)Vp + ro_ * ldv * 2; \
    sk[s][0] = *(const bf16x8*)(kb_ + ko[0]); \
    if constexpr (DQK == 128) sk[s][NKC - 1] = *(const bf16x8*)(kb_ + ko[NKC - 1]); \
    if constexpr (DQK == 96) sk[s][NKC - 1] = *(const bf16x8*)((const char*)Kp2 + ro_ * ldk2 * 2 + ko[NKC - 1]); \
    _Pragma("unroll") for (int i_ = 0; i_ < NVC; ++i_) sv[s][i_] = *(const bf16x8*)(vb_ + vo[i_]); } while (0)
#define SWRITE(slot, s) do { _Pragma("unroll") for (int i_ = 0; i_ < NVC; ++i_) *(bf16x8*)(V_lds + (slot) * SHM_V + vl[i_]) = sv[s][i_]; \
    _Pragma("unroll") for (int i_ = 0; i_ < NKC; ++i_) *(bf16x8*)(K_lds + (slot) * SHM_K + kl[i_]) = sk[s][i_]; } while (0)
#define RESC(a) do { if (__any((a) < 1.f)) { if (hi == 0) al_l[r32] = (a); asm volatile("s_waitcnt lgkmcnt(0)" ::: "memory"); \
    _Pragma("unroll") for (int d = 0; d < NCB; ++d) _Pragma("unroll") for (int r = 0; r < 16; ++r) o[d][r] *= al_l[crow(r, hi)]; } } while (0)
#define MASK(pa_, pb_, j) do { if constexpr (SWA) { if ((j) < NL) swa_mask(pa_, pb_, lo + 64 * (j), qpos, hi); } } while (0)
#define VSEG(t, DOQK_) do { SBAR(); softmax_tile<DQK, FAST>(pn0, pn1, m_reg, l_reg, alpha, pa0, pa1, pa2, pa3); if constexpr (!FAST) RESC(alpha); \
    if (DOQK_) { qkt<DQK>(pn0, pn1, K_lds + (((t) + 1) & 3) * SHM_K, qr, r32, hi); MASK(pn0, pn1, (t) + 1); }     \
    SBAR(); __syncthreads(); } while (0)
#define MSEG(t, STG, ALL_) do { SBAR(); \
    if (ALL_) { SWRITE(((t) + 3) & 3, STG); SLOAD(STG, (t) + 5); }        \
    else if ((t) + 3 < NT) { SWRITE(((t) + 3) & 3, STG); if ((t) + 5 < NT) SLOAD(STG, (t) + 5); } \
    const int vbt_ = vb0 + ((t) & 3) * SHM_V; \
    if constexpr (DV == 64) mseg_body<DQK, DV, false>(pn0, pn1, o, qr, ka0, vbt_, pa0, pa1, pa2, pa3); \
    else pv_all<NCB>(o, vbt_, pa0, pa1, pa2, pa3); \
    SBAR(); __syncthreads(); } while (0)
  f32x16 pn0, pn1; bf16x8 pa0, pa1, pa2, pa3;
  SLOAD(0, 0); SLOAD(1, 1);
  SWRITE(0, 0); if (2 < NT) SLOAD(0, 2);
  SWRITE(1, 1); if (3 < NT) SLOAD(1, 3);
  __syncthreads();
  if (grp1) __syncthreads();
  if (2 < NT) { SWRITE(2, 0); if (4 < NT) SLOAD(0, 4); }
  qkt<DQK>(pn0, pn1, K_lds, qr, r32, hi); MASK(pn0, pn1, 0);
  __syncthreads();
  int t = 0;
  for (; t + 6 < NT; t += 2) {
    VSEG(t, 1); MSEG(t, 1, 1);
    VSEG(t + 1, 1); MSEG(t + 1, 0, 1);
  }
  for (; t + 2 < NT; t += 2) {
    VSEG(t, 1); MSEG(t, 1, 0);
    VSEG(t + 1, 1); MSEG(t + 1, 0, 0);
  }
  VSEG(NT - 2, 1); MSEG(NT - 2, 1, 0);
  VSEG(NT - 1, 0); MSEG(NT - 1, 0, 0);
  if (!grp1) __syncthreads();
  if constexpr (SWA) l_reg += FAST ? __builtin_amdgcn_exp2f(sink_l2) : __builtin_amdgcn_exp2f(sink_l2 - m_reg * C);
  const bool bad = __any(!(l_reg > 1.0e-20f && l_reg < 1.0e30f));
  if (hi == 0) li_l[r32] = l_reg; asm volatile("s_waitcnt lgkmcnt(0)" ::: "memory");
#pragma unroll
  for (int r = 0; r < 16; ++r) { const float rl = __builtin_amdgcn_rcpf(li_l[crow(r, hi)]);
#pragma unroll
    for (int d = 0; d < NCB; ++d) o[d][r] *= rl; }
  __syncthreads();
  return bad;
#undef TROW
#undef SLOAD
#undef SWRITE
#undef RESC
#undef MASK
#undef VSEG
#undef MSEG
}

__device__ __forceinline__ void scale8(bf16x8& v, float c) { float f[8]; unpack8(v, f);
#pragma unroll
  for (int e = 0; e < 8; ++e) f[e] *= c;
  v = pack8(f); }
__device__ __forceinline__ bool wg_any(bool flag, char* lds) {
  volatile int* w = (volatile int*)lds;
  if (threadIdx.x == 0) w[0] = 0;
  __syncthreads();
  if (flag && (threadIdx.x & 63) == 0) w[0] = 1;
  __syncthreads();
  const bool r = w[0] != 0;
  __syncthreads();
  return r;
}
#define ATTN_PASS(DQK_, DV_, SWA_, ...) do { constexpr float Cq_ = ScaleOf<DQK_>::v * LOG2E; \
    _Pragma("unroll") for (int d0 = 0; d0 < DQK_ / 16; ++d0) scale8(qr[d0], Cq_); \
    bool bad_ = attn_core<DQK_, DV_, SWA_, true>(__VA_ARGS__); \
    if (wg_any(bad_, lds)) { _Pragma("unroll") for (int d0 = 0; d0 < DQK_ / 16; ++d0) scale8(qr[d0], 1.f / Cq_); \
      attn_core<DQK_, DV_, SWA_, false>(__VA_ARGS__); } } while (0)

template <int KIND>
__device__ __forceinline__ void attn_item(const P& p, int b, int h, int qb, bool is_ctx, char* lds) {
  constexpr int DQK = KIND == 0 ? 96 : KIND == 2 ? 128 : 64;
  constexpr int DV = (KIND == 1 || KIND == 2) ? 128 : 64;
  constexpr int NCB = DV / 32;
  int tid = threadIdx.x; LAUNDER_V(tid);
  const int wid = tid >> 6, lane = tid & 63, r32 = lane & 31, hi = lane >> 5;
  const int rowb = b * TPB;
  const int q_t0 = is_ctx ? SEQ : qb * 256;
  const int qt = q_t0 + wid * 32 + r32;
  const size_t qrow = (size_t)rowb + qt;
  const int krow0 = is_ctx ? rowb + SEQ : rowb;
  int NT, NL, lo;
  if (is_ctx) { NT = 4; NL = 4; lo = 0; }
  else if (KIND == 3) { lo = q_t0 - 128 < 0 ? 0 : q_t0 - 128; const int he = q_t0 + 384 > SEQ ? SEQ : q_t0 + 384; NL = (he - lo) / 64; NT = NL + 4; }
  else { NT = TPB / 64; NL = NT; lo = 0; }
  const float* rt = (const float*)(p.ws + WS_ROPE);
  const bf16_t* proj = (const bf16_t*)(p.ws + WS_PROJ);
  bf16_t* ob = (bf16_t*)(p.ws + WS_ABUF);
  const int prow = qt >> 6, pcol = qt & 63;
  f32x16 o[NCB];

  if constexpr (KIND == 1) {
    const float lam = ((const float*)(p.ws + WS_MISC))[0];
#pragma unroll 1
    for (int map = 0; map < 2; ++map) {
      const int m = 2 * h + map;
      bf16x8 qr[4];
      { const bf16_t* qp = proj + qrow * NPAD1 + m * 64 + hi * 8;
#pragma unroll
        for (int d0 = 0; d0 < 4; ++d0) qr[d0] = *(const bf16x8*)(qp + d0 * 16); }
      if (!is_ctx) {
        const float* T = rt + ROPE64_OFF;
        rope8(qr[0], qr[2], T + prow * 16 + hi * 8, T + 256 * 16 + prow * 16 + hi * 8);
        rope8(qr[1], qr[3], T + pcol * 16 + hi * 8, T + 256 * 16 + pcol * 16 + hi * 8);
      }
      ATTN_PASS(64, 128, false, o, qr, proj + (size_t)krow0 * NPAD1 + 1024 + m * 64, NPAD1, nullptr, 0,
                proj + (size_t)krow0 * NPAD1 + 2048 + h * 128, NPAD1, NT, NL, lo, qt, 0.f, lds);
      char* obw = (char*)(ob + ((size_t)rowb + q_t0) * 1024 + h * 128);
      const char* gbw = (const char*)(proj + ((size_t)rowb + q_t0) * NPAD1 + 3072 + h * 128);
      int te = threadIdx.x; LAUNDER_V(te);
      const int wid = te >> 6, r32 = te & 31, hi = (te >> 5) & 1;
      const unsigned oo = (unsigned)((wid * 32 + 4 * hi) * 1024 + r32) * 2u;
      const unsigned go = (unsigned)((wid * 32 + 4 * hi) * NPAD1 + r32) * 2u;
      if (map == 0) {
#pragma unroll
        for (int r = 0; r < 16; ++r) {
          const unsigned ro = oo + (unsigned)(((r & 3) + 8 * (r >> 2)) * 2048);
#pragma unroll
          for (int d = 0; d < 4; ++d) *(bf16_t*)(obw + ro + d * 64) = f2bf(o[d][r]);
          if ((r & 3) == 3) SBAR();
        }
      } else {
        float gs[4];
#pragma unroll
        for (int d = 0; d < 4; ++d) gs[d] = p.diff_g_sub[d * 32 + r32] * (1.f - LAMBDA_INIT);
#pragma unroll
        for (int r = 0; r < 16; ++r) {
          const unsigned ro = oo + (unsigned)(((r & 3) + 8 * (r >> 2)) * 2048);
          const unsigned rg = go + (unsigned)(((r & 3) + 8 * (r >> 2)) * (NPAD1 * 2));
          float dv[4]; float ss = 0.f;
#pragma unroll
          for (int d = 0; d < 4; ++d) { const float o1 = bf2f((short)*(const bf16_t*)(obw + ro + d * 64)); dv[d] = o1 - lam * o[d][r]; ss += dv[d] * dv[d]; }
          ss += __shfl_xor(ss, 1); ss += __shfl_xor(ss, 2); ss += __shfl_xor(ss, 4); ss += __shfl_xor(ss, 8); ss += __shfl_xor(ss, 16);
          const float rstd = rsqrtf(ss * (1.f / 128.f) + EPS);
#pragma unroll
          for (int d = 0; d < 4; ++d) {
            const float g = bf2f((short)*(const bf16_t*)(gbw + rg + d * 64));
            *(bf16_t*)(obw + ro + d * 64) = f2bf(dv[d] * rstd * gs[d] * silu_f(g));
          }
          if ((r & 1) == 1) SBAR();
        }
      }
    }
  } else {
    bf16x8 qr[DQK / 16];
    const bf16_t *Kp, *Kp2 = nullptr, *Vp, *gbase; int ldk, ldk2 = 0, ldv, ldg; float sink_l2 = 0.f;
    if constexpr (KIND == 0) {
      const bf16_t* q2 = (const bf16_t*)(p.ws + WS_X); const bf16_t* kv2 = (const bf16_t*)(p.ws + WS_KV2);
      const bf16_t* qp = q2 + qrow * 1536 + h * 96 + hi * 8;
#pragma unroll
      for (int d0 = 0; d0 < 6; ++d0) qr[d0] = *(const bf16x8*)(qp + d0 * 16);
      if (!is_ctx) { const int pos = hi ? pcol : prow; const float* T = rt + ROPE32_OFF; rope8(qr[4], qr[5], T + pos * 8, T + 256 * 8 + pos * 8); }
      Kp = kv2 + (size_t)krow0 * 2048 + h * 128; ldk = 2048; Kp2 = proj + (size_t)krow0 * NPAD0 + 384; ldk2 = NPAD0;
      Vp = kv2 + (size_t)krow0 * 2048 + h * 128 + 64; ldv = 2048;
      gbase = proj + ((size_t)rowb + q_t0) * NPAD0 + 416 + h * 64; ldg = NPAD0;
    } else if constexpr (KIND == 2) {
      const bf16_t* qp = proj + qrow * NPAD2 + h * 128 + hi * 8;
      float ss = 0.f; float xf[8][8];
#pragma unroll
      for (int d0 = 0; d0 < 8; ++d0) { unpack8(*(const bf16x8*)(qp + d0 * 16), xf[d0]);
#pragma unroll
        for (int e = 0; e < 8; ++e) ss += xf[d0][e] * xf[d0][e]; }
      ss += __shfl_xor(ss, 32);
      const float rstd = rsqrtf(ss * (1.f / 128.f) + EPS);
#pragma unroll
      for (int d0 = 0; d0 < 8; ++d0) {
        const f32x4 g0 = *(const f32x4*)(p.gqa_g_q + d0 * 16 + hi * 8), g1 = *(const f32x4*)(p.gqa_g_q + d0 * 16 + hi * 8 + 4);
#pragma unroll
        for (int e = 0; e < 8; ++e) xf[d0][e] *= rstd * (e < 4 ? g0[e & 3] : g1[e & 3]);
      }
      if (!is_ctx) {
        const float* T = rt + ROPE128_OFF;
#pragma unroll
        for (int d0 = 0; d0 < 4; ++d0) { const int pos = d0 < 2 ? prow : pcol; const int f0 = (d0 & 1) * 16 + hi * 8;
          rope8f(xf[d0], xf[d0 + 4], T + pos * 32 + f0, T + 256 * 32 + pos * 32 + f0); }
      }
#pragma unroll
      for (int d0 = 0; d0 < 8; ++d0) qr[d0] = pack8(xf[d0]);
      const int kvh = h >> 2;
      Kp = proj + (size_t)krow0 * NPAD2 + 1024 + kvh * 128; ldk = NPAD2; Vp = proj + (size_t)krow0 * NPAD2 + 1280 + kvh * 128; ldv = NPAD2;
      gbase = proj + ((size_t)rowb + q_t0) * NPAD2 + 1536 + h * 128; ldg = NPAD2;
    } else {
      const bf16_t* qp = proj + qrow * NPAD3 + h * 64 + hi * 8;
#pragma unroll
      for (int d0 = 0; d0 < 4; ++d0) qr[d0] = *(const bf16x8*)(qp + d0 * 16);
      if (!is_ctx) {
        const float* T = rt + ROPE64_OFF;
        rope8(qr[0], qr[2], T + prow * 16 + hi * 8, T + 256 * 16 + prow * 16 + hi * 8);
        rope8(qr[1], qr[3], T + pcol * 16 + hi * 8, T + 256 * 16 + pcol * 16 + hi * 8);
      }
      const int kvh = h >> 3;
      Kp = proj + (size_t)krow0 * NPAD3 + 1024 + kvh * 64; ldk = NPAD3; Vp = proj + (size_t)krow0 * NPAD3 + 1152 + kvh * 64; ldv = NPAD3;
      gbase = proj + ((size_t)rowb + q_t0) * NPAD3 + 1280 + h * 64; ldg = NPAD3;
      sink_l2 = p.swa_sink[h] * LOG2E;
    }
    ATTN_PASS(DQK, DV, KIND == 3, o, qr, Kp, ldk, Kp2, ldk2, Vp, ldv, NT, NL, lo, qt, sink_l2, lds);
    char* obw = (char*)(ob + ((size_t)rowb + q_t0) * 1024 + h * DV);
    const char* gbw = (const char*)gbase;
    int te = threadIdx.x; LAUNDER_V(te);
    const int wid2 = te >> 6, r32b = te & 31, hi2 = (te >> 5) & 1;
    const unsigned oo = (unsigned)((wid2 * 32 + 4 * hi2) * 1024 + r32b) * 2u;
    const unsigned go = (unsigned)((wid2 * 32 + 4 * hi2) * ldg + r32b) * 2u;
#pragma unroll
    for (int r = 0; r < 16; ++r) {
      const unsigned ro = oo + (unsigned)(((r & 3) + 8 * (r >> 2)) * 2048);
      const unsigned rg = go + (unsigned)(((r & 3) + 8 * (r >> 2)) * ldg * 2);
#pragma unroll
      for (int d = 0; d < NCB; ++d) {
        const float g = bf2f((short)*(const bf16_t*)(gbw + rg + d * 64));
        *(bf16_t*)(obw + ro + d * 64) = f2bf(o[d][r] * silu_f(g));
      }
      if ((r & 3) == 3) SBAR();
    }
  }
}

template <int KIND>
__device__ __forceinline__ void phase_attn(const P& p, char* lds) {
  constexpr int H = (KIND == 0 || KIND == 3) ? 16 : 8;
  constexpr int nlat = NBATCH * H * 64, nctx = KIND < 3 ? NBATCH * H : 0;
  for (int it = blockIdx.x; it < nlat + nctx; it += gridDim.x) {
    if (it < nlat) {
      int qb = it & 63, hh = it >> 6;
      if (gridDim.x == 256) {
        const int x = it & 7, j = (it & 255) >> 3; hh = (it >> 8) * 4 + (x >> 1); qb = j + 32 * (x & 1);
      }
      attn_item<KIND>(p, hh / H, hh % H, qb, false, lds);
    }
    else { const int j = it - nlat; attn_item<KIND>(p, j / H, j % H, 0, true, lds); }
  }
}

__device__ __forceinline__ P load_params() {
#if defined(__HIP_DEVICE_COMPILE__)
  auto pp = (const __attribute__((address_space(4))) P*)__builtin_amdgcn_kernarg_segment_ptr();
  asm volatile("" : "+s"(pp));
  return *pp;
#else
  return P{};
#endif
}
__global__ __launch_bounds__(NTHR) void mega(P p_unused) {
  extern __shared__ __attribute__((aligned(16))) char lds[];
  cg::grid_group grid = cg::this_grid();
  phase_prep(load_params(), lds); grid.sync();
#define GSYNC(k) grid_barrier((unsigned*)(load_params().ws + WS_BAR), (unsigned)(k))
  phase_h0(load_params()); GSYNC(1);
#pragma unroll 1
  for (int layer = 0; layer < 4; ++layer) {
    const int e0 = 2 + 5 * layer;
    phase_gemm1(load_params(), layer, lds); GSYNC(e0);
    if (layer == 0) { phase_kfix<0>(load_params()); phase_gemm2(load_params(), lds); }
    else if (layer == 1) phase_kfix<1>(load_params());
    else if (layer == 2) phase_kfix<2>(load_params());
    else phase_kfix<3>(load_params());
    GSYNC(e0 + 1);
    if (layer == 0) phase_attn<0>(load_params(), lds);
    else if (layer == 1) phase_attn<1>(load_params(), lds);
    else if (layer == 2) phase_attn<2>(load_params(), lds);
    else phase_attn<3>(load_params(), lds);
    GSYNC(e0 + 2);
    phase_outproj(load_params(), layer, lds); GSYNC(e0 + 3);
    phase_ln(load_params(), layer);
    if (layer < 3) GSYNC(e0 + 4);
  }
}

extern "C" void kernel_launch(void* const* d_in, const int* in_sizes, int n_in, void* d_out, int out_size, void* d_ws, size_t ws_size, hipStream_t stream) {
  static int grid_blocks = 0;
  if (!grid_blocks) {
    if (ws_size < WS_END) { fprintf(stderr, "kernel_launch: workspace too small: %zu < %zu\n", ws_size, (size_t)WS_END); return; }
    if (hipFuncSetAttribute((const void*)mega, hipFuncAttributeMaxDynamicSharedMemorySize, LDS_BYTES) != hipSuccess) { fprintf(stderr, "kernel_launch: LDS attribute failed\n"); return; }
    int dev = 0, cus = 0, per_cu = 0;
    hipGetDevice(&dev);
    hipDeviceGetAttribute(&cus, hipDeviceAttributeMultiprocessorCount, dev);
    hipOccupancyMaxActiveBlocksPerMultiprocessor(&per_cu, mega, NTHR, LDS_BYTES);
    if (per_cu < 1) { fprintf(stderr, "kernel_launch: occupancy 0\n"); return; }
    grid_blocks = cus * 1;
  }
  P p{};
  p.x = (const float*)d_in[0]; p.c = (const float*)d_in[1]; p.ctx = (const float*)d_in[2]; p.c_ctx = (const float*)d_in[3];
  p.ada_w = (const float*)d_in[4]; p.ada_b = (const float*)d_in[5]; p.out_w = (const float*)d_in[6]; p.ln_g = (const float*)d_in[7]; p.ln_b = (const float*)d_in[8];
  p.mla_w_in = (const float*)d_in[9]; p.mla_g_qa = (const float*)d_in[10]; p.mla_w_qb = (const float*)d_in[11]; p.mla_g_kva = (const float*)d_in[12]; p.mla_w_kvb = (const float*)d_in[13];
  p.diff_w_in = (const float*)d_in[14]; p.diff_lambda = (const float*)d_in[15]; p.diff_g_sub = (const float*)d_in[16];
  p.gqa_w_in = (const float*)d_in[17]; p.gqa_g_q = (const float*)d_in[18]; p.gqa_g_k = (const float*)d_in[19];
  p.swa_w_in = (const float*)d_in[20]; p.swa_sink = (const float*)d_in[21];
  p.out = (float*)d_out; p.ws = (char*)d_ws;
  hipMemsetAsync((char*)d_ws + WS_BAR, 0, 256, stream);
  void* args[] = {&p};
  hipError_t e = hipLaunchCooperativeKernel((const void*)mega, dim3(grid_blocks), dim3(NTHR), args, LDS_BYTES, stream);
  if (e != hipSuccess) fprintf(stderr, "cooperative launch failed: %s (grid %d)\n", hipGetErrorString(e), grid_blocks);
}
```
